# Optimizing an MI355X kernel written in HIP

```python
import math
import jax, jax.numpy as jnp
from jax import lax
import numpy as np

D_MODEL = 1024
BATCH = 4
SEQ = 4096
DEPTH = 4

N_A_LAYERS = max(1, DEPTH // 2)
N_B_LAYERS = DEPTH - N_A_LAYERS

DIFF_HEADS = 8
DIFF_QK_DIM = 64
DIFF_V_DIM = 2 * DIFF_QK_DIM
T5_BUCKETS = 32
T5_MAX_DISTANCE = 128
MLA_HEADS = 16
MLA_QK_NOPE = 128
MLA_QK_ROPE = 64
MLA_V_DIM = 128
MLA_Q_LORA = 512
MLA_KV_LORA = 256
ROPE_BASE = 10000.0
D_FF = 2816
CONV_WIDTH = 3
PLE_DIM = 256
Q_BLOCK = 128
RMS_EPS = 1e-6
NEG_INF = -1e30
POS_OFFSET_MAX = 1024

kernel_name = 'yoco_diffattn_mla_convffn_hybrid'


def rms_norm(x, gain):
    xf = x.astype(jnp.float32)
    y = xf * lax.rsqrt(jnp.mean(xf * xf, axis=-1, keepdims=True) + RMS_EPS)
    return (y * gain.astype(jnp.float32)).astype(x.dtype)


def rotary(x, pos):
    d = x.shape[-1]
    half = d // 2
    inv_freq = jnp.exp(-math.log(ROPE_BASE) * jnp.arange(half, dtype=jnp.float32) * (2.0 / d))
    ang = pos.astype(jnp.float32)[..., None] * inv_freq
    if x.ndim == 4:
        ang = ang[:, :, None, :]
    cos, sin = jnp.cos(ang), jnp.sin(ang)
    xf = x.astype(jnp.float32)
    x1, x2 = xf[..., :half], xf[..., half:]
    return jnp.concatenate([x1 * cos - x2 * sin, x1 * sin + x2 * cos], axis=-1).astype(x.dtype)


def t5_bucket(dist):
    n = jnp.maximum(dist, 0)
    max_exact = T5_BUCKETS // 2
    log_ratio = jnp.log(jnp.maximum(n, 1).astype(jnp.float32) / max_exact) / math.log(T5_MAX_DISTANCE / max_exact)
    large = max_exact + (log_ratio * (T5_BUCKETS - max_exact)).astype(jnp.int32)
    large = jnp.minimum(large, T5_BUCKETS - 1)
    return jnp.where(n < max_exact, n, large)


def to_blocks(t):
    b, s = t.shape[:2]
    return t.reshape((b, s // Q_BLOCK, Q_BLOCK) + t.shape[2:]).swapaxes(0, 1)


def from_blocks(t):
    nb, b, q = t.shape[:3]
    return t.swapaxes(0, 1).reshape((b, nb * q) + t.shape[3:])


def causal_mask(blk_idx, seq):
    q_idx = blk_idx * Q_BLOCK + jnp.arange(Q_BLOCK)
    return jnp.arange(seq)[None, :] <= q_idx[:, None]


def diff_attention(h, pos, w_qkv, q_gain, k_gain, lam_q1, lam_k1, lam_q2, lam_k2, sub_gain, w_o, rel_table, lam_init):
    b, s, _ = h.shape
    qk_w = DIFF_HEADS * 2 * DIFF_QK_DIM
    qkv = h @ w_qkv
    q = rms_norm(qkv[..., :qk_w].reshape(b, s, DIFF_HEADS, 2, DIFF_QK_DIM), q_gain)
    k = rms_norm(qkv[..., qk_w:2 * qk_w].reshape(b, s, DIFF_HEADS, 2, DIFF_QK_DIM), k_gain)
    v = qkv[..., 2 * qk_w:].reshape(b, s, DIFF_HEADS, DIFF_V_DIM)
    f32 = jnp.float32
    lam = (jnp.exp(jnp.sum(lam_q1.astype(f32) * lam_k1.astype(f32)))
           - jnp.exp(jnp.sum(lam_q2.astype(f32) * lam_k2.astype(f32))) + lam_init)
    scale = DIFF_QK_DIM ** -0.5
    nb = s // Q_BLOCK

    def block(args):
        i, q_blk, p_blk = args
        sc = jnp.einsum('bqhcd,bkhcd->bhcqk', q_blk, k).astype(f32) * scale
        bucket = t5_bucket(p_blk[:, :, None] - pos[:, None, :])
        bias = jnp.take(rel_table, bucket, axis=0).astype(f32)
        bias = bias.transpose(0, 3, 1, 2)[:, :, None]
        sc = jnp.where(causal_mask(i, s), sc + bias, NEG_INF)
        a = jax.nn.softmax(sc, axis=-1)
        wts = a[:, :, 0] - lam * a[:, :, 1]
        return jnp.einsum('bhqk,bkhv->bqhv', wts.astype(v.dtype), v)

    o = lax.map(block, (jnp.arange(nb), to_blocks(q), to_blocks(pos)))
    o = from_blocks(o)
    o = rms_norm(o, sub_gain) * (1.0 - lam_init)
    return o.reshape(b, s, DIFF_HEADS * DIFF_V_DIM) @ w_o


def shared_latent_kv(h, pos, kv_norm, w_dkv, ckv_norm, w_ukv, k_nope_norm, k_pe_norm):
    b, s, _ = h.shape
    hn = rms_norm(h, kv_norm)
    ckv_full = hn @ w_dkv
    c_kv = rms_norm(ckv_full[..., :MLA_KV_LORA], ckv_norm)
    k_pe = rotary(rms_norm(ckv_full[..., MLA_KV_LORA:], k_pe_norm), pos)
    kv = (c_kv @ w_ukv).reshape(b, s, MLA_HEADS, MLA_QK_NOPE + MLA_V_DIM)
    k_nope = rms_norm(kv[..., :MLA_QK_NOPE], k_nope_norm)
    v = kv[..., MLA_QK_NOPE:]
    return k_nope, k_pe, v


def mla_attention(h, pos, w_dq, cq_norm, w_uq, q_nope_norm, q_pe_norm, w_o, k_nope, k_pe, v):
    b, s, _ = h.shape
    c_q = rms_norm(h @ w_dq, cq_norm)
    q = (c_q @ w_uq).reshape(b, s, MLA_HEADS, MLA_QK_NOPE + MLA_QK_ROPE)
    q_nope = rms_norm(q[..., :MLA_QK_NOPE], q_nope_norm)
    q_pe = rotary(rms_norm(q[..., MLA_QK_NOPE:], q_pe_norm), pos)
    scale = (MLA_QK_NOPE + MLA_QK_ROPE) ** -0.5
    nb = s // Q_BLOCK

    def block(args):
        i, qn, qp = args
        sc = (jnp.einsum('bqhd,bkhd->bhqk', qn, k_nope)
              + jnp.einsum('bqhr,bkr->bhqk', qp, k_pe)).astype(jnp.float32) * scale
        sc = jnp.where(causal_mask(i, s), sc, NEG_INF)
        a = jax.nn.softmax(sc, axis=-1)
        return jnp.einsum('bhqk,bkhv->bqhv', a.astype(v.dtype), v)

    o = from_blocks(lax.map(block, (jnp.arange(nb), to_blocks(q_nope), to_blocks(q_pe))))
    return o.reshape(b, s, MLA_HEADS * MLA_V_DIM) @ w_o


def conv_gated_ffn(h, w_in, conv_w, conv_b, w_out):
    s = h.shape[1]
    u = h @ w_in
    u_pad = jnp.pad(u, ((0, 0), (CONV_WIDTH - 1, 0), (0, 0)))
    c = conv_b
    for j in range(CONV_WIDTH):
        c = c + u_pad[:, j:j + s, :] * conv_w[j]
    a, g = jnp.split(c, 2, axis=-1)
    return (jax.nn.silu(g) * a) @ w_out


def per_layer_embedding(h, p_i, norm_g, w_proj, w_gate):
    gate = jax.nn.sigmoid(rms_norm(h, norm_g) @ w_gate)
    return (p_i @ w_proj) * gate


def setup_inputs(seed: int = 0) -> dict:
    key = jax.random.key(seed)
    keys = iter(jax.random.split(key, 48))
    f32 = jnp.float32

    def dense(shape, fan_in):
        return jax.random.normal(next(keys), shape, f32) * fan_in ** -0.5

    def gain(shape):
        return 1.0 + 0.05 * jax.random.normal(next(keys), shape, f32)

    def small(shape, scale):
        return scale * jax.random.normal(next(keys), shape, f32)

    na, nbl = N_A_LAYERS, N_B_LAYERS
    qkv_w = 2 * DIFF_HEADS * 2 * DIFF_QK_DIM + DIFF_HEADS * DIFF_V_DIM
    x = jax.random.normal(next(keys), (BATCH, SEQ, D_MODEL), f32)
    p = jax.random.normal(next(keys), (DEPTH, BATCH, SEQ, PLE_DIM), f32)
    offsets = jax.random.randint(next(keys), (BATCH, 1), 0, POS_OFFSET_MAX, dtype=jnp.int32)
    positions = offsets + jnp.arange(SEQ, dtype=jnp.int32)[None, :]
    return {
        'x': x,
        'p': p,
        'positions': positions,
        'rel_bias_table': small((T5_BUCKETS, DIFF_HEADS), 0.5),
        'attn_norm': gain((DEPTH, D_MODEL)),
        'a_w_qkv': dense((na, D_MODEL, qkv_w), D_MODEL),
        'a_q_norm': gain((na, DIFF_QK_DIM)),
        'a_k_norm': gain((na, DIFF_QK_DIM)),
        'a_lam_q1': small((na, DIFF_QK_DIM), 0.1),
        'a_lam_k1': small((na, DIFF_QK_DIM), 0.1),
        'a_lam_q2': small((na, DIFF_QK_DIM), 0.1),
        'a_lam_k2': small((na, DIFF_QK_DIM), 0.1),
        'a_sub_norm': gain((na, DIFF_V_DIM)),
        'a_w_o': dense((na, DIFF_HEADS * DIFF_V_DIM, D_MODEL), DIFF_HEADS * DIFF_V_DIM),
        'kv_norm': gain((D_MODEL,)),
        'w_dkv': dense((D_MODEL, MLA_KV_LORA + MLA_QK_ROPE), D_MODEL),
        'ckv_norm': gain((MLA_KV_LORA,)),
        'w_ukv': dense((MLA_KV_LORA, MLA_HEADS * (MLA_QK_NOPE + MLA_V_DIM)), MLA_KV_LORA),
        'k_nope_norm': gain((MLA_QK_NOPE,)),
        'k_pe_norm': gain((MLA_QK_ROPE,)),
        'b_w_dq': dense((nbl, D_MODEL, MLA_Q_LORA), D_MODEL),
        'b_cq_norm': gain((nbl, MLA_Q_LORA)),
        'b_w_uq': dense((nbl, MLA_Q_LORA, MLA_HEADS * (MLA_QK_NOPE + MLA_QK_ROPE)), MLA_Q_LORA),
        'b_q_nope_norm': gain((nbl, MLA_QK_NOPE)),
        'b_q_pe_norm': gain((nbl, MLA_QK_ROPE)),
        'b_w_o': dense((nbl, MLA_HEADS * MLA_V_DIM, D_MODEL), MLA_HEADS * MLA_V_DIM),
        'ffn_norm': gain((DEPTH, D_MODEL)),
        'ffn_w_in': dense((DEPTH, D_MODEL, 2 * D_FF), D_MODEL),
        'ffn_conv_w': dense((DEPTH, CONV_WIDTH, 2 * D_FF), CONV_WIDTH),
        'ffn_conv_b': small((DEPTH, 2 * D_FF), 0.02),
        'ffn_w_out': dense((DEPTH, D_FF, D_MODEL), D_FF),
        'ple_norm': gain((DEPTH, D_MODEL)),
        'ple_w_proj': dense((DEPTH, PLE_DIM, D_MODEL), PLE_DIM),
        'ple_w_gate': dense((DEPTH, D_MODEL, D_MODEL), D_MODEL),
    }


def reference(x, p, positions, rel_bias_table, attn_norm,
              a_w_qkv, a_q_norm, a_k_norm, a_lam_q1, a_lam_k1, a_lam_q2, a_lam_k2, a_sub_norm, a_w_o,
              kv_norm, w_dkv, ckv_norm, w_ukv, k_nope_norm, k_pe_norm,
              b_w_dq, b_cq_norm, b_w_uq, b_q_nope_norm, b_q_pe_norm, b_w_o,
              ffn_norm, ffn_w_in, ffn_conv_w, ffn_conv_b, ffn_w_out,
              ple_norm, ple_w_proj, ple_w_gate):
    h = x
    shared = None
    for i in range(DEPTH):
        hn = rms_norm(h, attn_norm[i])
        if i < N_A_LAYERS:
            lam_init = 0.8 - 0.6 * math.exp(-0.3 * i)
            mix = diff_attention(hn, positions, a_w_qkv[i], a_q_norm[i], a_k_norm[i],
                                 a_lam_q1[i], a_lam_k1[i], a_lam_q2[i], a_lam_k2[i],
                                 a_sub_norm[i], a_w_o[i], rel_bias_table, lam_init)
        else:
            if shared is None:
                shared = shared_latent_kv(h, positions, kv_norm, w_dkv, ckv_norm, w_ukv,
                                          k_nope_norm, k_pe_norm)
            j = i - N_A_LAYERS
            k_nope, k_pe, v = shared
            mix = mla_attention(hn, positions, b_w_dq[j], b_cq_norm[j], b_w_uq[j],
                                b_q_nope_norm[j], b_q_pe_norm[j], b_w_o[j], k_nope, k_pe, v)
        h = h + mix
        h = h + conv_gated_ffn(rms_norm(h, ffn_norm[i]), ffn_w_in[i], ffn_conv_w[i],
                               ffn_conv_b[i], ffn_w_out[i])
        h = h + per_layer_embedding(h, p[i], ple_norm[i], ple_w_proj[i], ple_w_gate[i])
    return h
```

```cpp
#include <hip/hip_runtime.h>
#include <hip/hip_cooperative_groups.h>
#include <cstdio>
#include <cstdint>
namespace cg = cooperative_groups;
#ifndef PROBE_BITS
#define PROBE_BITS 0
#endif

#define LAS __attribute__((address_space(3)))
typedef unsigned short bf16_t;
typedef short bf16x8 __attribute__((ext_vector_type(8)));
typedef short s16x4 __attribute__((ext_vector_type(4)));
typedef float f32x2 __attribute__((ext_vector_type(2)));
typedef float f32x4 __attribute__((ext_vector_type(4)));
typedef float f32x16 __attribute__((ext_vector_type(16)));
typedef unsigned u32x2 __attribute__((ext_vector_type(2)));
typedef unsigned u32x4 __attribute__((ext_vector_type(4)));
typedef __bf16 nbf16x2 __attribute__((ext_vector_type(2)));
#define DI __device__ __forceinline__
#define SCHED_B __builtin_amdgcn_sched_barrier(0)

constexpr int T = 16384, S = 4096, NB = 4, D = 1024;
constexpr int DFF = 2816;
constexpr float EPS = 1e-6f;
constexpr float LOG2E = 1.4426950408889634f;

constexpr size_t MiB = 1u << 20;
constexpr size_t WS_SS = 0;
constexpr size_t WS_CTL = 6 * MiB + 512 * 1024;
constexpr size_t WS_PB = 7 * MiB;
constexpr size_t WS_WATT = 15 * MiB;
constexpr size_t WS_WFFN = 26 * MiB;
constexpr size_t WS_X = 47 * MiB;
constexpr size_t WS_Y = 81 * MiB;
constexpr size_t WS_R3 = 114 * MiB;
constexpr size_t WS_R4 = 244 * MiB;
constexpr size_t WS_CS = 340 * MiB;
constexpr size_t WS_END = 344 * MiB;
constexpr int SS_IN = 0, SS_H1 = 16, SS_H2 = 32, SS_CQ = 48, SS_CKV = 56;

constexpr int RING_BYTES = 131072;
constexpr int XCH_OFF = RING_BYTES;
constexpr int LUT_OFF = RING_BYTES + 8192;
constexpr int KPOS_OFF = LUT_OFF + 1024;
constexpr int BARST_OFF = KPOS_OFF + 1024;
constexpr int LDS_BYTES = 147456;

DI unsigned pk2(float a, float b) { f32x2 v = {a, b}; nbf16x2 r = __builtin_convertvector(v, nbf16x2); return __builtin_bit_cast(unsigned, r); }
DI float bf_lo(unsigned u) { return __builtin_bit_cast(float, u << 16); }
DI float bf_hi(unsigned u) { return __builtin_bit_cast(float, u & 0xffff0000u); }
DI int lane_asm();
DI float shx(float v, int mask, int ln) { return __builtin_bit_cast(float, __builtin_amdgcn_ds_bpermute((ln ^ mask) << 2, __builtin_bit_cast(int, v))); }
DI int shxi(int v, int mask, int ln) { return __builtin_amdgcn_ds_bpermute((ln ^ mask) << 2, v); }
DI float shl(float v, int src) { return __builtin_bit_cast(float, __builtin_amdgcn_ds_bpermute(src << 2, __builtin_bit_cast(int, v))); }
template <int N> DI float dpp_ror(float v) { return __builtin_bit_cast(float, __builtin_amdgcn_update_dpp(0, __builtin_bit_cast(int, v), 0x120 + N, 0xF, 0xF, false)); }
DI float wave_sum(float v, int ln) {
#pragma unroll
    for (int o = 1; o < 64; o <<= 1) v += shx(v, o, ln);
    return v;
}
DI float rsq(float x) { return 1.0f / sqrtf(x); }
DI int lane_asm() { int l; asm volatile("v_mbcnt_lo_u32_b32 %0, -1, 0\n\tv_mbcnt_hi_u32_b32 %0, -1, %0" : "=v"(l)); return l; }

namespace pg8 {
constexpr int BM = 256, BK = 64, HALF = 128, HTB = HALF * BK * 2, NXCD = 8, WGM = 8;
__host__ __device__ __forceinline__ int lds_byte(int r, int c) { const int st = (r >> 4) * 2 + (c >> 5), rr = r & 15, cc = c & 31, ob = rr * 64 + cc * 2; return st * 1024 + (ob ^ (((ob >> 9) & 1) << 5)); }
__host__ __device__ __forceinline__ void stage_rc(int b, int& R, int& C) { const int st = b / 1024, sb = b % 1024, swz = sb ^ (((sb >> 9) & 1) << 5); R = (st >> 1) * 16 + swz / 64; C = (st & 1) * 32 + (swz % 64) / 2; }

__host__ __device__ __forceinline__ int perm32(int rho) { const int n = rho >> 4, i = rho & 15; return 8 * (i >> 2) + 4 * n + (i & 3); }
struct Unit { int pm, pn; };
struct Gemm { const bf16_t* A; const bf16_t* Bt; int K; int ovl; };
DI long a_row0(const Gemm& g, int pm) { return g.ovl ? (long)(pm / 17) * S + 254 * (pm % 17) - 2 : (long)pm * BM; }

struct StaticOrder {
    int nM, nN, nwg, G, c;
    DI void init(int nM_, int nN_, int G_, int c_) { nM = nM_; nN = nN_; nwg = nM * nN; G = G_; c = c_; }
    DI bool next(int i, Unit& u) const {
        const long L = (long)i * G + c; if (L >= nwg) return false;
        int wgid = (int)L; { const int q = nwg / NXCD, r = nwg % NXCD, xcd = wgid % NXCD, off = wgid / NXCD; wgid = (xcd < r ? xcd * (q + 1) : r * (q + 1) + (xcd - r) * q) + off; }
        const int nig = WGM * nN, gid = wgid / nig, fm = gid * WGM, gsz = (nM - fm) < WGM ? (nM - fm) : WGM;
        u.pm = fm + ((wgid % nig) % gsz); u.pn = (wgid % nig) / gsz; return true;
    }
};

template <class Epi, bool ALIGN_EPI>
DI void gemm_phase1(LAS unsigned char* lds, const Gemm g, const StaticOrder& Sd, const Epi& E, const int wid_in, const int dry) {
    int wid = wid_in; asm volatile("" : "+s"(wid));
    const int lane = lane_asm(), tid = wid * 64 + lane;
    const int wr = wid >> 2, wc = wid & 3, fr = lane & 15, fq = lane >> 4;
    int K = g.K; asm volatile("" : "+s"(K));
    const int nt = K / BK;
    unsigned voffA[2], voffB[2];
#pragma unroll
    for (int i = 0; i < 2; ++i) { int R, C; stage_rc(tid * 16 + i * 8192, R, C); const int Rb = Epi::PERM ? ((R & ~31) + perm32(R & 31)) : R; voffB[i] = (unsigned)(Rb * K + C) * 2u;
        const int Ra = g.ovl ? ((R & 64) | ((R & 15) << 2) | ((R >> 4) & 3)) : R;
        voffA[i] = (unsigned)(Ra * K + C) * 2u; }
    const size_t kstep = (size_t)(BK * 2);
    const size_t hstep = (size_t)HALF * K * 2;
    const size_t tstep = 2 * hstep;
    const size_t rowb = (size_t)K * 2;
    const unsigned ldsw = (unsigned)wid * 1024u;
    const int aoff = lds_byte(wr * 64 + fr, fq * 8), boff = lds_byte(wc * 32 + fr, fq * 8);
#define PG8_SA(b, h) (((b) * 2 + (h)) * HTB)
#define PG8_SB(b, h) ((4 + (b) * 2 + (h)) * HTB)
#define PG8_STAGE(bufoff, gbase, voff) do { _Pragma("unroll") for (int _i = 0; _i < 2; ++_i) \
        __builtin_amdgcn_global_load_lds((const unsigned*)((const char*)(gbase) + (voff)[_i]), (LAS unsigned*)(lds + (bufoff) + ldsw + _i * 8192), 16, 0, 0); } while (0)
#define PG8_LDA(dst, b, h) do { _Pragma("unroll") for (int m = 0; m < 4; ++m) _Pragma("unroll") for (int k = 0; k < 2; ++k) dst[m][k] = *(const LAS bf16x8*)(lds + PG8_SA(b, h) + aoff + m * 2048 + k * 1024); } while (0)
#define PG8_LDB(dst, b, h) do { _Pragma("unroll") for (int n = 0; n < 2; ++n) _Pragma("unroll") for (int k = 0; k < 2; ++k) dst[n][k] = *(const LAS bf16x8*)(lds + PG8_SB(b, h) + boff + n * 2048 + k * 1024); } while (0)
#define PG8_MMA(ai, bj, At, Bt) do { __builtin_amdgcn_s_setprio(1); _Pragma("unroll") for (int m = 0; m < 4; ++m) _Pragma("unroll") for (int n = 0; n < 2; ++n) _Pragma("unroll") for (int k = 0; k < 2; ++k) \
        acc[ai][bj][m][n] = __builtin_amdgcn_mfma_f32_16x16x32_bf16(Bt[n][k], At[m][k], acc[ai][bj][m][n], 0, 0, 0); __builtin_amdgcn_s_setprio(0); } while (0)
#define PG8_WAIT_V(n) asm volatile("s_waitcnt vmcnt(" #n ")" ::: "memory")
#define PG8_WAIT_L(n) asm volatile("s_waitcnt lgkmcnt(" #n ")" ::: "memory")
#define PG8_BAR __builtin_amdgcn_s_barrier()
#define PG8_SCHED __builtin_amdgcn_sched_barrier(0)
    Unit cur, nxt; int ui = 0;
    if (!Sd.next(0, cur)) return;
    f32x4 acc[2][2][4][2];
#pragma unroll
    for (int a = 0; a < 2; ++a)
#pragma unroll
        for (int b = 0; b < 2; ++b)
#pragma unroll
            for (int m = 0; m < 4; ++m)
#pragma unroll
                for (int n = 0; n < 2; ++n) acc[a][b][m][n] = (f32x4){0.f, 0.f, 0.f, 0.f};
    bf16x8 At[4][2], B0[2][2], B1[2][2];
    const char* cA = (const char*)g.A + a_row0(g, cur.pm) * (long)rowb; const char* cB = (const char*)g.Bt + (size_t)cur.pn * tstep;
    {
        PG8_STAGE(PG8_SB(0, 0), cB, voffB); PG8_STAGE(PG8_SB(0, 1), cB + hstep, voffB); PG8_STAGE(PG8_SA(0, 0), cA, voffA); PG8_STAGE(PG8_SA(0, 1), cA + hstep, voffA);
        if (wr == 1) PG8_BAR;
        PG8_WAIT_V(2); PG8_BAR;
        PG8_STAGE(PG8_SB(1, 0), cB + kstep, voffB); PG8_STAGE(PG8_SA(1, 0), cA + kstep, voffA); PG8_STAGE(PG8_SB(1, 1), cB + hstep + kstep, voffB);
        PG8_WAIT_V(6); PG8_BAR;
    }
    for (;;) {
        const bool has_next = Sd.next(ui + 1, nxt);
        const char* nA = has_next ? (const char*)g.A + a_row0(g, nxt.pm) * (long)rowb : cA; const char* nB = has_next ? (const char*)g.Bt + (size_t)nxt.pn * tstep : cB;
        for (int t = 0; t < nt; t += 2) {
            const bool last = (t == nt - 2);
            const char* a1 = cA + (size_t)(t + 1) * kstep;
            const char* a2 = last ? nA : cA + (size_t)(t + 2) * kstep; const char* b2 = last ? nB : cB + (size_t)(t + 2) * kstep;
            const char* a3 = a2 + kstep; const char* b3 = b2 + kstep;
            PG8_LDB(B0, 0, 0); PG8_LDB(B1, 0, 1); PG8_SCHED; PG8_LDA(At, 0, 0); PG8_STAGE(PG8_SA(1, 1), a1 + hstep, voffA);
            PG8_WAIT_V(8); PG8_WAIT_L(0); PG8_BAR; PG8_MMA(0, 0, At, B0); PG8_MMA(0, 1, At, B1); PG8_BAR; PG8_SCHED;
            PG8_LDA(At, 0, 1); PG8_STAGE(PG8_SB(0, 0), b2, voffB); PG8_STAGE(PG8_SB(0, 1), b2 + hstep, voffB); PG8_STAGE(PG8_SA(0, 0), a2, voffA);
            PG8_WAIT_V(8); PG8_WAIT_L(0); PG8_BAR; PG8_MMA(1, 0, At, B0); PG8_MMA(1, 1, At, B1); PG8_BAR; PG8_SCHED;
            PG8_LDB(B0, 1, 0); PG8_LDB(B1, 1, 1); PG8_SCHED; PG8_LDA(At, 1, 0); PG8_STAGE(PG8_SA(0, 1), a2 + hstep, voffA);
            PG8_WAIT_V(8); PG8_WAIT_L(0); PG8_BAR; PG8_MMA(0, 0, At, B0); PG8_MMA(0, 1, At, B1); PG8_BAR; PG8_SCHED;
            PG8_LDA(At, 1, 1); PG8_STAGE(PG8_SB(1, 0), b3, voffB); PG8_STAGE(PG8_SB(1, 1), b3 + hstep, voffB); PG8_STAGE(PG8_SA(1, 0), a3, voffA);
            PG8_WAIT_V(8); PG8_WAIT_L(0); PG8_BAR; PG8_MMA(1, 0, At, B0); PG8_MMA(1, 1, At, B1); PG8_BAR; PG8_SCHED;
        }
        if constexpr (ALIGN_EPI) { if (wr == 0) PG8_BAR; }
        { int fr_ = fr, fq_ = fq; asm volatile("" : "+v"(fr_), "+v"(fq_)); E(acc, cur, wr, wc, fr_, fq_, dry != 0); }
        if (!has_next) break;
#pragma unroll
        for (int a = 0; a < 2; ++a)
#pragma unroll
            for (int b = 0; b < 2; ++b)
#pragma unroll
                for (int m = 0; m < 4; ++m)
#pragma unroll
                    for (int n = 0; n < 2; ++n) acc[a][b][m][n] = (f32x4){0.f, 0.f, 0.f, 0.f};
        cur = nxt; cA = nA; cB = nB; ++ui;
        if constexpr (ALIGN_EPI) { if (wr == 1) PG8_BAR; }
    }
    PG8_WAIT_V(0);
    if constexpr (!ALIGN_EPI) { if (wr == 0) PG8_BAR; }
    PG8_BAR;
#undef PG8_SA
#undef PG8_SB
#undef PG8_STAGE
#undef PG8_LDA
#undef PG8_LDB
#undef PG8_MMA
#undef PG8_WAIT_V
#undef PG8_WAIT_L
#undef PG8_BAR
#undef PG8_SCHED
}
template <class Epi, bool ALIGN_EPI>
DI void gemm_phase(LAS unsigned char* lds, const Gemm g, const StaticOrder& Sd, const Epi& E, const int wid, const int nrep = 1, const long pflag = 0) {
    for (int rep = 0; rep < nrep; ++rep) gemm_phase1<Epi, ALIGN_EPI>(lds, g, Sd, E, wid, (rep < nrep - 1) && pflag != 0);
}
}
using pg8::Unit;
typedef f32x4 AccT[2][2][4][2];

DI int vperm16(int k) { return ((k >> 2) & 1) * 8 + (k >> 3) * 4 + (k & 3); }
DI void store_bf4(bf16_t* p, f32x4 v) { u32x2 w; w.x = pk2(v[0], v[1]); w.y = pk2(v[2], v[3]); *(u32x2*)p = w; }
DI float dot4(f32x4 v) { return (v[0] * v[0] + v[1] * v[1]) + (v[2] * v[2] + v[3] * v[3]); }

DI float sum16(const float* p) { const f32x4 a = *(const f32x4*)p, b = *(const f32x4*)(p + 4), c = *(const f32x4*)(p + 8), d = *(const f32x4*)(p + 12);
    return (((a[0] + a[1]) + (a[2] + a[3])) + ((b[0] + b[1]) + (b[2] + b[3]))) + (((c[0] + c[1]) + (c[2] + c[3])) + ((d[0] + d[1]) + (d[2] + d[3]))); }
DI float sum16c(const float* p, int fq, int ln) { const f32x4 a = *(const f32x4*)(p + fq * 4); float t = (a[0] + a[1]) + (a[2] + a[3]); t += shx(t, 16, ln); t += shx(t, 32, ln); return t; }
DI float sum8(const float* p) { const f32x4 a = *(const f32x4*)p, b = *(const f32x4*)(p + 4); return ((a[0] + a[1]) + (a[2] + a[3])) + ((b[0] + b[1]) + (b[2] + b[3])); }
DI float sum4(const float* p) { const f32x4 a = *(const f32x4*)p; return (a[0] + a[1]) + (a[2] + a[3]); }
struct EpiRes {
    static constexpr bool PERM = true;
    bf16_t* hb; float* ss;
    DI void operator()(AccT& acc, const Unit& u, int wr, int wc, int fr, int fq, const bool dry) const {
#pragma unroll
        for (int ai = 0; ai < 2; ++ai)
#pragma unroll
            for (int m = 0; m < 4; ++m) {
                const size_t row = (size_t)u.pm * 256 + ai * 128 + wr * 64 + m * 16 + fr; float sq = 0.f;
#pragma unroll
                for (int bj = 0; bj < 2; ++bj) {
                    const size_t off = row * D + u.pn * 256 + bj * 128 + wc * 32 + fq * 8;
                    const u32x4 hw = *(const u32x4*)(hb + off);
                    const f32x4 v0 = (f32x4){bf_lo(hw.x), bf_hi(hw.x), bf_lo(hw.y), bf_hi(hw.y)} + acc[ai][bj][m][0];
                    const f32x4 v1 = (f32x4){bf_lo(hw.z), bf_hi(hw.z), bf_lo(hw.w), bf_hi(hw.w)} + acc[ai][bj][m][1];
                    u32x4 o; o.x = pk2(v0[0], v0[1]); o.y = pk2(v0[2], v0[3]); o.z = pk2(v1[0], v1[1]); o.w = pk2(v1[2], v1[3]);
                    *(u32x4*)(hb + off) = dry ? hw : o;
                    sq += dot4(v0) + dot4(v1);
                }
                sq += shx(sq, 16, fq * 16 + fr); sq += shx(sq, 32, fq * 16 + fr);
                if (fq == 0 && !dry) ss[row * 16 + u.pn * 4 + wc] = sq;
            }
    }
};
struct EpiPlain {
    static constexpr bool PERM = true;
    bf16_t* out;
    DI void operator()(AccT& acc, const Unit& u, int wr, int wc, int fr, int fq, const bool dry) const {
#pragma unroll
        for (int ai = 0; ai < 2; ++ai)
#pragma unroll
            for (int m = 0; m < 4; ++m) {
                const size_t row = (size_t)u.pm * 256 + ai * 128 + wr * 64 + m * 16 + fr;
#pragma unroll
                for (int bj = 0; bj < 2; ++bj) { const f32x4 v0 = acc[ai][bj][m][0], v1 = acc[ai][bj][m][1];
                    u32x4 o; o.x = pk2(v0[0], v0[1]); o.y = pk2(v0[2], v0[3]); o.z = pk2(v1[0], v1[1]); o.w = pk2(v1[2], v1[3]);
                    *(u32x4*)(out + row * D + u.pn * 256 + bj * 128 + wc * 32 + fq * 8) = o; }
            }
    }
};
struct EpiPle {
    static constexpr bool PERM = true;
    const bf16_t* hin; bf16_t* ot; float* outf; const float* ss_in; float* ss_out;
    DI void operator()(AccT& acc, const Unit& u, int wr, int wc, int fr, int fq, const bool dry) const {
        float rsv[2][4];
#pragma unroll
        for (int ai = 0; ai < 2; ++ai)
#pragma unroll
            for (int m = 0; m < 4; ++m) { const size_t row = (size_t)u.pm * 256 + ai * 128 + wr * 64 + m * 16 + fr; rsv[ai][m] = rsq(sum16c(ss_in + row * 16, fq, fq * 16 + fr) * (1.0f / D) + EPS); }
#pragma unroll
        for (int ai = 0; ai < 2; ++ai)
#pragma unroll
            for (int m = 0; m < 4; ++m) {
                const size_t row = (size_t)u.pm * 256 + ai * 128 + wr * 64 + m * 16 + fr; float sq = 0.f;
                const float rs = rsv[ai][m];
#pragma unroll
                for (int bj = 0; bj < 2; ++bj) {
                    const size_t off = row * D + u.pn * 256 + bj * 128 + wc * 32 + fq * 8;
                    const u32x4 pw = *(const u32x4*)(ot + off), hw = *(const u32x4*)(hin + off);
                    const f32x4 pp0 = {bf_lo(pw.x), bf_hi(pw.x), bf_lo(pw.y), bf_hi(pw.y)}, pp1 = {bf_lo(pw.z), bf_hi(pw.z), bf_lo(pw.w), bf_hi(pw.w)};
                    f32x4 v0 = {bf_lo(hw.x), bf_hi(hw.x), bf_lo(hw.y), bf_hi(hw.y)}, v1 = {bf_lo(hw.z), bf_hi(hw.z), bf_lo(hw.w), bf_hi(hw.w)};
                    const f32x4 g0 = acc[ai][bj][m][0] * rs, g1 = acc[ai][bj][m][1] * rs;
#pragma unroll
                    for (int e = 0; e < 4; ++e) { v0[e] += pp0[e] * __builtin_amdgcn_rcpf(1.0f + __builtin_amdgcn_exp2f(-LOG2E * g0[e])); v1[e] += pp1[e] * __builtin_amdgcn_rcpf(1.0f + __builtin_amdgcn_exp2f(-LOG2E * g1[e])); }
                    if (outf) { if (!dry) { *(f32x4*)(outf + off) = v0; *(f32x4*)(outf + off + 4) = v1; } }
                    else { u32x4 o; o.x = pk2(v0[0], v0[1]); o.y = pk2(v0[2], v0[3]); o.z = pk2(v1[0], v1[1]); o.w = pk2(v1[2], v1[3]); *(u32x4*)(ot + off) = dry ? pw : o; }
                    sq += dot4(v0) + dot4(v1);
                }
                if (ss_out) { sq += shx(sq, 16, fq * 16 + fr); sq += shx(sq, 32, fq * 16 + fr); if (fq == 0 && !dry) ss_out[row * 16 + u.pn * 4 + wc] = sq; }
            }
    }
};
struct EpiQkvA {
    static constexpr bool PERM = true;
    const float* ss_in; const float* qg; const float* kg; bf16_t* Q; bf16_t* Kb; bf16_t* Vt;
    DI void operator()(AccT& acc, const Unit& u, int wr, int wc, int fr, int fq, const bool dry) const {
        const float live = dry ? 0.f : 1.f; (void)live;
        const int L = u.pn * 256 + wc * 64;
        float rsv[2][4];
#pragma unroll
        for (int ai = 0; ai < 2; ++ai)
#pragma unroll
            for (int m = 0; m < 4; ++m) { const size_t row = (size_t)u.pm * 256 + ai * 128 + wr * 64 + m * 16 + fr; rsv[ai][m] = rsq(sum16c(ss_in + row * 16, fq, fq * 16 + fr) * (1.0f / D) + EPS); }
#pragma unroll
        for (int ai = 0; ai < 2; ++ai)
#pragma unroll
            for (int m = 0; m < 4; ++m) {
                const size_t row = (size_t)u.pm * 256 + ai * 128 + wr * 64 + m * 16 + fr;
                const float rs = rsv[ai][m];
                if (u.pn < 8) {
                    float sq = 0.f;
#pragma unroll
                    for (int bj = 0; bj < 2; ++bj)
#pragma unroll
                        for (int n = 0; n < 2; ++n) { acc[ai][bj][m][n] *= rs; sq += dot4(acc[ai][bj][m][n]); }
                    sq += shx(sq, 16, fq * 16 + fr); sq += shx(sq, 32, fq * 16 + fr);
                    float rg = rsq(sq * (1.0f / 64.0f) + EPS);
                    const float* gp = (u.pn < 4) ? qg : kg; if (u.pn < 4) rg *= 0.125f * LOG2E;
                    bf16_t* dst = (u.pn < 4) ? Q + row * 1024 + L : Kb + row * 1024 + (L - 1024);
#pragma unroll
                    for (int bj = 0; bj < 2; ++bj) { const int d = 32 * bj + 8 * fq; const f32x4 g0 = *(const f32x4*)(gp + d), g1 = *(const f32x4*)(gp + d + 4);
                        { const f32x4 a_ = acc[ai][bj][m][0] * g0 * rg, b_ = acc[ai][bj][m][1] * g1 * rg; u32x4 o_; o_.x = pk2(a_[0], a_[1]); o_.y = pk2(a_[2], a_[3]); o_.z = pk2(b_[0], b_[1]); o_.w = pk2(b_[2], b_[3]); *(u32x4*)(dst + d) = o_; } }
                } else {
                    const int b = (int)(row >> 12), s_ = (int)(row & 4095), s = (s_ & ~15) | vperm16(s_ & 15);
#pragma unroll
                    for (int bj = 0; bj < 2; ++bj)
#pragma unroll
                        for (int n = 0; n < 2; ++n) {
                            const int lv = L - 2048 + 32 * bj + 8 * fq + 4 * n;
                            bf16_t* p = Vt + ((size_t)b * 1024 + lv) * S + s;
                            const f32x4 v = acc[ai][bj][m][n] * rs;
                            const unsigned w0 = pk2(v[0], v[1]), w1 = pk2(v[2], v[3]);
                            p[0] = (bf16_t)(w0 & 0xffff); p[S] = (bf16_t)(w0 >> 16); p[2 * S] = (bf16_t)(w1 & 0xffff); p[3 * S] = (bf16_t)(w1 >> 16);
                            SCHED_B;
                        }
                }
                SCHED_B;
            }
    }
};
struct EpiDq {
    static constexpr bool PERM = true;
    const float* ss_in; bf16_t* cq; bf16_t* ckv; bf16_t* Kpe; const float* gpe; const f32x2* cst; float* ss_cq; float* ss_ckv;
    DI void operator()(AccT& acc, const Unit& u, int wr, int wc, int fr, int fq, const bool dry) const {
        float rsv[2][4];
#pragma unroll
        for (int ai = 0; ai < 2; ++ai)
#pragma unroll
            for (int m = 0; m < 4; ++m) { const size_t row = (size_t)u.pm * 256 + ai * 128 + wr * 64 + m * 16 + fr; rsv[ai][m] = rsq(sum16c(ss_in + row * 16, fq, fq * 16 + fr) * (1.0f / D) + EPS); }
#pragma unroll
        for (int ai = 0; ai < 2; ++ai)
#pragma unroll
            for (int m = 0; m < 4; ++m) {
                const size_t row = (size_t)u.pm * 256 + ai * 128 + wr * 64 + m * 16 + fr;
                const float rs = rsv[ai][m]; float sq = 0.f;
                if (u.pn < 3) {
#pragma unroll
                    for (int bj = 0; bj < 2; ++bj) {
                        const int c = bj * 128 + wc * 32 + fq * 8; const f32x4 v0 = acc[ai][bj][m][0] * rs, v1 = acc[ai][bj][m][1] * rs;
                        bf16_t* dp = (u.pn < 2) ? cq + row * 512 + u.pn * 256 + c : ckv + row * 256 + c;
                        { const f32x4 a_ = v0, b_ = v1; u32x4 o_; o_.x = pk2(a_[0], a_[1]); o_.y = pk2(a_[2], a_[3]); o_.z = pk2(b_[0], b_[1]); o_.w = pk2(b_[2], b_[3]); *(u32x4*)(dp) = o_; }
                        sq += dot4(v0) + dot4(v1);
                    }
                    sq += shx(sq, 16, fq * 16 + fr); sq += shx(sq, 32, fq * 16 + fr);
                    if (fq == 0 && !dry) { if (u.pn < 2) ss_cq[row * 8 + u.pn * 4 + wc] = sq; else ss_ckv[row * 4 + wc] = sq; }
                } else if (wc == 0) {
#pragma unroll
                    for (int bj = 0; bj < 2; ++bj)
#pragma unroll
                        for (int n = 0; n < 2; ++n) { acc[ai][bj][m][n] *= rs; sq += dot4(acc[ai][bj][m][n]); }
                    sq += shx(sq, 16, fq * 16 + fr); sq += shx(sq, 32, fq * 16 + fr);
                    const float rg = rsq(sq * (1.0f / 64.0f) + EPS);
#pragma unroll
                    for (int n = 0; n < 2; ++n) {
                        const int d = fq * 8 + n * 4;
                        const f32x4 g1 = *(const f32x4*)(gpe + d), g2 = *(const f32x4*)(gpe + 32 + d);
                        const f32x4 c01 = *(const f32x4*)(cst + row * 32 + d), c23 = *(const f32x4*)(cst + row * 32 + d + 2);
                        const f32x4 y1 = acc[ai][0][m][n] * g1 * rg, y2 = acc[ai][1][m][n] * g2 * rg;
                        const f32x4 cs = {c01[0], c01[2], c23[0], c23[2]}, sn = {c01[1], c01[3], c23[1], c23[3]};
                        store_bf4(Kpe + row * 64 + d, y1 * cs - y2 * sn); store_bf4(Kpe + row * 64 + 32 + d, y1 * sn + y2 * cs);
                    }
                }
            }
    }
};
struct EpiUq {
    static constexpr bool PERM = true;
    const float* ss_cq; bf16_t* Qn; bf16_t* Qp; const float* gqn; const float* gqp; const f32x2* cst; LAS float* xch;
    DI void operator()(AccT& acc, const Unit& u, int wr, int wc, int fr, int fq, const bool dry) const {
        const float scq = 0.07216878364870322f * LOG2E;
        const int ln = fq * 16 + fr;
        if (u.pn < 8) {
#pragma unroll
            for (int ai = 0; ai < 2; ++ai)
#pragma unroll
                for (int m = 0; m < 4; ++m) {
                    const int rl = ai * 128 + wr * 64 + m * 16 + fr; const size_t row = (size_t)u.pm * 256 + rl;
                    const float rs = rsq(sum8(ss_cq + row * 8) * (1.0f / 512.0f) + EPS);
#pragma unroll
                    for (int bj = 0; bj < 2; ++bj) {
                        float sq = 0.f;
#pragma unroll
                        for (int n = 0; n < 2; ++n) { acc[ai][bj][m][n] *= rs; sq += dot4(acc[ai][bj][m][n]); }
                        sq += shx(sq, 16, ln); sq += shx(sq, 32, ln);
                        if (fq == 0) xch[(rl * 2 + bj) * 4 + wc] = sq;
                    }
                }
            asm volatile("s_waitcnt lgkmcnt(0)" ::: "memory"); __builtin_amdgcn_s_barrier(); asm volatile("" ::: "memory");
#pragma unroll
            for (int ai = 0; ai < 2; ++ai)
#pragma unroll
                for (int m = 0; m < 4; ++m) {
                    const int rl = ai * 128 + wr * 64 + m * 16 + fr; const size_t row = (size_t)u.pm * 256 + rl;
#pragma unroll
                    for (int bj = 0; bj < 2; ++bj) {
                        const f32x4 pt = *(const LAS f32x4*)(xch + (rl * 2 + bj) * 4);
                        const float rg = rsq(((pt[0] + pt[1]) + (pt[2] + pt[3])) * (1.0f / 128.0f) + EPS) * scq;
                        { const int c = wc * 32 + fq * 8; const f32x4 g0 = *(const f32x4*)(gqn + c), g1 = *(const f32x4*)(gqn + c + 4);
                            { const f32x4 a_ = acc[ai][bj][m][0] * g0 * rg, b_ = acc[ai][bj][m][1] * g1 * rg; u32x4 o_; o_.x = pk2(a_[0], a_[1]); o_.y = pk2(a_[2], a_[3]); o_.z = pk2(b_[0], b_[1]); o_.w = pk2(b_[2], b_[3]); *(u32x4*)(Qn + row * 2048 + (2 * u.pn + bj) * 128 + c) = o_; } }
                    }
                }
        } else {
            const int head = (u.pn - 8) * 4 + wc;
#pragma unroll
            for (int ai = 0; ai < 2; ++ai)
#pragma unroll
                for (int m = 0; m < 4; ++m) {
                    const size_t row = (size_t)u.pm * 256 + ai * 128 + wr * 64 + m * 16 + fr;
                    const float rs = rsq(sum8(ss_cq + row * 8) * (1.0f / 512.0f) + EPS); float sq = 0.f;
#pragma unroll
                    for (int bj = 0; bj < 2; ++bj)
#pragma unroll
                        for (int n = 0; n < 2; ++n) { acc[ai][bj][m][n] *= rs; sq += dot4(acc[ai][bj][m][n]); }
                    sq += shx(sq, 16, ln); sq += shx(sq, 32, ln);
                    const float rg = rsq(sq * (1.0f / 64.0f) + EPS) * scq;
#pragma unroll
                    for (int n = 0; n < 2; ++n) {
                        const int d = fq * 8 + n * 4;
                        const f32x4 g1 = *(const f32x4*)(gqp + d), g2 = *(const f32x4*)(gqp + 32 + d);
                        const f32x4 c01 = *(const f32x4*)(cst + row * 32 + d), c23 = *(const f32x4*)(cst + row * 32 + d + 2);
                        const f32x4 y1 = acc[ai][0][m][n] * g1 * rg, y2 = acc[ai][1][m][n] * g2 * rg;
                        const f32x4 cs = {c01[0], c01[2], c23[0], c23[2]}, sn = {c01[1], c01[3], c23[1], c23[3]};
                        store_bf4(Qp + row * 1024 + head * 64 + d, y1 * cs - y2 * sn); store_bf4(Qp + row * 1024 + head * 64 + 32 + d, y1 * sn + y2 * cs);
                    }
                }
        }
    }
};
struct EpiUkv {
    static constexpr bool PERM = true;
    const float* ss_ckv; bf16_t* Kn; bf16_t* Vt; const float* gk; LAS float* xch;
    DI void operator()(AccT& acc, const Unit& u, int wr, int wc, int fr, int fq, const bool dry) const {
        const int ln = fq * 16 + fr;
#pragma unroll
        for (int ai = 0; ai < 2; ++ai)
#pragma unroll
            for (int m = 0; m < 4; ++m) {
                const int rl = ai * 128 + wr * 64 + m * 16 + fr; const size_t row = (size_t)u.pm * 256 + rl;
                const float rs = rsq(sum4(ss_ckv + row * 4) * (1.0f / 256.0f) + EPS); float sq = 0.f;
#pragma unroll
                for (int n = 0; n < 2; ++n) { acc[ai][0][m][n] *= rs; sq += dot4(acc[ai][0][m][n]); acc[ai][1][m][n] *= rs; }
                sq += shx(sq, 16, ln); sq += shx(sq, 32, ln);
                if (fq == 0) xch[rl * 4 + wc] = sq;
            }
        asm volatile("s_waitcnt lgkmcnt(0)" ::: "memory"); __builtin_amdgcn_s_barrier(); asm volatile("" ::: "memory");
#pragma unroll
        for (int ai = 0; ai < 2; ++ai)
#pragma unroll
            for (int m = 0; m < 4; ++m) {
                const int rl = ai * 128 + wr * 64 + m * 16 + fr; const size_t row = (size_t)u.pm * 256 + rl;
                const f32x4 pt = *(const LAS f32x4*)(xch + rl * 4);
                const float rg = rsq(((pt[0] + pt[1]) + (pt[2] + pt[3])) * (1.0f / 128.0f) + EPS);
                { const int c = wc * 32 + fq * 8; const f32x4 g0 = *(const f32x4*)(gk + c), g1 = *(const f32x4*)(gk + c + 4);
                    { const f32x4 a_ = acc[ai][0][m][0] * g0 * rg, b_ = acc[ai][0][m][1] * g1 * rg; u32x4 o_; o_.x = pk2(a_[0], a_[1]); o_.y = pk2(a_[2], a_[3]); o_.z = pk2(b_[0], b_[1]); o_.w = pk2(b_[2], b_[3]); *(u32x4*)(Kn + row * 2048 + u.pn * 128 + c) = o_; } }
            }
        const size_t row0 = (size_t)u.pm * 256 + wr * 64 + fr;
        const int b = (int)(row0 >> 12), s0_ = (int)(row0 & 4095), s0 = (s0_ & ~15) | vperm16(s0_ & 15);
        bf16_t* vb = Vt + ((size_t)(b * 16 + u.pn) * 128 + wc * 32 + fq * 8) * S + s0;
#pragma unroll
        for (int ai = 0; ai < 2; ++ai)
#pragma unroll
            for (int m = 0; m < 4; ++m)
#pragma unroll
                for (int n = 0; n < 2; ++n) {
                    bf16_t* p = vb + (size_t)(n * 4) * S + ai * 128 + m * 16;
                    const f32x4 v = acc[ai][1][m][n];
                    const unsigned w0 = pk2(v[0], v[1]), w1 = pk2(v[2], v[3]);
                    p[0] = (bf16_t)(w0 & 0xffff); p[S] = (bf16_t)(w0 >> 16); p[2 * S] = (bf16_t)(w1 & 0xffff); p[3 * S] = (bf16_t)(w1 >> 16);
                    SCHED_B;
                }
    }
};
struct EpiFfnIn {
    static constexpr bool PERM = false;
    const float* ss; const float* cw; const float* cb; bf16_t* act; LAS float* xch;
    template <int CTRL> static DI float dppo(float old, float v) { return __builtin_bit_cast(float, __builtin_amdgcn_update_dpp(__builtin_bit_cast(int, old), __builtin_bit_cast(int, v), CTRL, 0xF, 0xF, false)); }
    DI void operator()(AccT& acc, const Unit& u, int wr, int wc, int fr, int fq, const bool dry) const {
        const int bidx = u.pm / 17, sbase = 254 * (u.pm % 17) - 2;
#pragma unroll
        for (int ai = 0; ai < 2; ++ai)
#pragma unroll
            for (int m = 0; m < 4; ++m) {
                int s = sbase + ai * 128 + wr * 64 + fr * 4 + m; s = s < 0 ? 0 : (s > S - 1 ? S - 1 : s);
                const float rs = rsq(sum16c(ss + (size_t)(bidx * S + s) * 16, fq, fq * 16 + fr) * (1.0f / D) + EPS);
#pragma unroll
                for (int bj = 0; bj < 2; ++bj)
#pragma unroll
                    for (int n = 0; n < 2; ++n) acc[ai][bj][m][n] *= rs;
            }
        if (fr == 15) {
#pragma unroll
            for (int ai = 0; ai < 2; ++ai)
#pragma unroll
                for (int bj = 0; bj < 2; ++bj)
#pragma unroll
                    for (int n = 0; n < 2; ++n) {
                        LAS float* xp = xch + (2 * ai + wr) * 512 + bj * 128 + wc * 32 + n * 16 + fq * 4;
                        *(LAS f32x4*)xp = acc[ai][bj][2][n]; *(LAS f32x4*)(xp + 256) = acc[ai][bj][3][n];
                    }
        }
        asm volatile("s_waitcnt lgkmcnt(0)" ::: "memory"); __builtin_amdgcn_s_barrier(); asm volatile("" ::: "memory");
#pragma unroll
        for (int n = 0; n < 2; ++n) {
            const int cl = wc * 32 + n * 16 + fq * 4, ch = u.pn * 128 + cl;
            const f32x4 wa0 = *(const f32x4*)(cw + ch), wa1 = *(const f32x4*)(cw + 2 * DFF + ch), wa2 = *(const f32x4*)(cw + 4 * DFF + ch), ba = *(const f32x4*)(cb + ch);
            const f32x4 wg0 = *(const f32x4*)(cw + DFF + ch), wg1 = *(const f32x4*)(cw + 3 * DFF + ch), wg2 = *(const f32x4*)(cw + 5 * DFF + ch), bg = *(const f32x4*)(cb + DFF + ch);
#pragma unroll
            for (int ai = 0; ai < 2; ++ai) {
                const int blk = 2 * ai + wr;
                f32x4 X0a = {0.f, 0.f, 0.f, 0.f}, X1a = X0a, X0g = X0a, X1g = X0a;
                if (blk > 0) { const LAS float* xb = xch + (blk - 1) * 512; X0a = *(const LAS f32x4*)(xb + cl); X1a = *(const LAS f32x4*)(xb + 256 + cl); X0g = *(const LAS f32x4*)(xb + 128 + cl); X1g = *(const LAS f32x4*)(xb + 256 + 128 + cl); }
                f32x4 q2a, q3a, q2g, q3g;
#pragma unroll
                for (int e = 0; e < 4; ++e) { q2a[e] = dppo<0x111>(X0a[e], acc[ai][0][2][n][e]); q3a[e] = dppo<0x111>(X1a[e], acc[ai][0][3][n][e]);
                                              q2g[e] = dppo<0x111>(X0g[e], acc[ai][1][2][n][e]); q3g[e] = dppo<0x111>(X1g[e], acc[ai][1][3][n][e]); }
                const f32x4 zero4 = {0.f, 0.f, 0.f, 0.f};
                const bool first = (sbase < 0) && (blk == 0) && (fr == 0);
#pragma unroll
                for (int m = 0; m < 4; ++m) {
                    const f32x4 ua = acc[ai][0][m][n], ug = acc[ai][1][m][n];
                    f32x4 p1a = (m == 0) ? q3a : acc[ai][0][m > 0 ? m - 1 : 0][n], p1g = (m == 0) ? q3g : acc[ai][1][m > 0 ? m - 1 : 0][n];
                    f32x4 p2a = (m == 0) ? q2a : (m == 1) ? q3a : acc[ai][0][m > 1 ? m - 2 : 0][n], p2g = (m == 0) ? q2g : (m == 1) ? q3g : acc[ai][1][m > 1 ? m - 2 : 0][n];
                    if (m == 2 && first) { p1a = zero4; p1g = zero4; p2a = zero4; p2g = zero4; }
                    if (m == 3 && first) { p2a = zero4; p2g = zero4; }
                    const f32x4 ca = ba + wa0 * p2a + wa1 * p1a + wa2 * ua;
                    const f32x4 cg_ = bg + wg0 * p2g + wg1 * p1g + wg2 * ug;
                    f32x4 o;
#pragma unroll
                    for (int e = 0; e < 4; ++e) o[e] = ca[e] * cg_[e] * __builtin_amdgcn_rcpf(1.0f + __builtin_amdgcn_exp2f(-LOG2E * cg_[e]));
                    const int Rt = ai * 128 + wr * 64 + fr * 4 + m, s = sbase + Rt;
                    if (Rt >= 2 && s < S) store_bf4(act + ((size_t)bidx * S + s) * DFF + ch, o);
                }
                SCHED_B;
            }
        }
    }
};

struct AttnArgs {
    const bf16_t* Q; const bf16_t* Q2; const bf16_t* K; const bf16_t* K2; const bf16_t* Vt; bf16_t* O;
    const int* pos; const float* ss_q; const float* gn; const float* gp; const f32x2* cs;
    int dry; const int* pmax; const float* rel; const float* lq1; const float* lk1; const float* lq2; const float* lk2; const float* subg; float lam_init;
};
DI int crow(int i, int h) { return (i & 3) + 8 * (i >> 2) + 4 * h; }
template <int SI> DI bf16x8 pack8(const f32x16& x) {
    u32x4 p; p.x = pk2(x[8 * SI], x[8 * SI + 1]); p.y = pk2(x[8 * SI + 2], x[8 * SI + 3]); p.z = pk2(x[8 * SI + 4], x[8 * SI + 5]); p.w = pk2(x[8 * SI + 6], x[8 * SI + 7]);
    return __builtin_bit_cast(bf16x8, p);
}
#define MFMA32(a, b, c) __builtin_amdgcn_mfma_f32_32x32x16_bf16((a), (b), (c), 0, 0, 0)

template <bool DIFF>
DI void attn_unit(const AttnArgs& a, LAS unsigned char* lds, int b, int head, int qb, const int wid_in) {
    int wid = wid_in; asm volatile("" : "+s"(wid));
    constexpr int DQK = DIFF ? 64 : 192, NKS = DQK / 16, KST = DQK * 2 + 16, KBYTES = 64 * KST, VST = 144, NH = DIFF ? 8 : 16;
    constexpr int NKL = DIFF ? 1 : 3;
    const int lane = lane_asm(), tid = wid * 64 + lane, r = lane & 31, h = lane >> 5;
    const int qw = qb * 256 + wid * 32, nt = (qb + 1) * 4, jlast = qw >> 5;
    const int pvar = PROBE_BITS ? (a.dry >> 1) : 0;
    const size_t tokq = (size_t)b * S + qw + r;
    LAS float* lut = (LAS float*)(lds + LUT_OFF);
    const int qpos = a.pos[tokq];
    int qpmin = qpos; unsigned long long nearA = 0, nearB = 0;
    float lam = 0.f;
    if constexpr (DIFF) {
#pragma unroll
        for (int o = 1; o < 64; o <<= 1) { const int t2 = shxi(qpmin, o, lane); qpmin = t2 < qpmin ? t2 : qpmin; }
        qpmin = __builtin_amdgcn_readfirstlane(qpmin);
        nearA = __builtin_amdgcn_ballot_w64(qpmin - a.pmax[b * 128 + lane] < 255); nearB = __builtin_amdgcn_ballot_w64(qpmin - a.pmax[b * 128 + 64 + lane] < 255);
        const float s1 = wave_sum(a.lq1[lane] * a.lk1[lane], lane), s2 = wave_sum(a.lq2[lane] * a.lk2[lane], lane);
        lam = expf(s1) - expf(s2) + a.lam_init;
    }
    f32x16 O[4];

    for (int c = 0; c < (DIFF ? 2 : 1); ++c) {
        bf16x8 qf[NKS];
        if constexpr (DIFF) {
#pragma unroll
            for (int ks = 0; ks < NKS; ++ks) qf[ks] = *(const bf16x8*)(a.Q + tokq * 1024 + head * 128 + c * 64 + ks * 16 + h * 8);
        } else {
#pragma unroll
            for (int ks = 0; ks < 8; ++ks) qf[ks] = *(const bf16x8*)(a.Q + tokq * 2048 + head * 128 + ks * 16 + h * 8);
#pragma unroll
            for (int ks = 0; ks < 4; ++ks) qf[8 + ks] = *(const bf16x8*)(a.Q2 + tokq * 1024 + head * 64 + ks * 16 + h * 8);
        }
        float mrun = 0.f, lrun = 0.f;
#pragma unroll
        for (int v = 0; v < 4; ++v)
#pragma unroll
            for (int i = 0; i < 16; ++i) O[v][i] = 0.f;

        constexpr int VBYTES = 128 * VST;
        u32x4 kreg[NKL], vreg[2]; int kpreg = 0;
        LAS int* kposl = (LAS int*)(lds + KPOS_OFF);
        const unsigned voffK = DIFF ? (unsigned)((tid >> 3) * 2048 + (tid & 7) * 16) : (unsigned)((tid >> 3) * 4096 + (tid & 7) * 16);
        const unsigned voffK2 = (unsigned)((tid >> 3) * 128 + (tid & 7) * 16);
        const unsigned voffV = (unsigned)((tid >> 3) * (S * 2) + (tid & 7) * 16);
        auto load_tile = [&](int t) {
            const int key0 = t * 64;
            if constexpr (DIFF) {
                const char* kb_ = (const char*)(a.K + ((size_t)b * S + key0) * 1024 + head * 128 + c * 64);
                kreg[0] = *(const u32x4*)(kb_ + voffK);
                if (tid < 64) kpreg = a.pos[(size_t)b * S + key0 + tid];
            } else {
                const char* kb_ = (const char*)(a.K + ((size_t)b * S + key0) * 2048 + head * 128);
                const char* k2_ = (const char*)(a.K2 + ((size_t)b * S + key0) * 64);
                kreg[0] = *(const u32x4*)(kb_ + voffK); kreg[1] = *(const u32x4*)(kb_ + voffK + 128); kreg[2] = *(const u32x4*)(k2_ + voffK2);
            }
            const char* vb_ = (const char*)(a.Vt + (size_t)(b * NH + head) * 128 * S + key0);
            vreg[0] = *(const u32x4*)(vb_ + voffV); vreg[1] = *(const u32x4*)(vb_ + (size_t)64 * S * 2 + voffV);
        };
        auto store_tile = [&](int kb, int vb) {
            LAS unsigned char* kp = lds + kb * KBYTES;
            if constexpr (DIFF) {
                const int row = tid >> 3, cc = tid & 7; *(LAS u32x4*)(kp + row * KST + cc * 16) = kreg[0];
                if (tid < 64) kposl[vb * 64 + tid] = kpreg;
            } else {
                { LAS unsigned char* kq = kp + (tid >> 3) * KST + (tid & 7) * 16; *(LAS u32x4*)kq = kreg[0]; *(LAS u32x4*)(kq + 128) = kreg[1]; *(LAS u32x4*)(kq + 256) = kreg[2]; }
            }
#pragma unroll
            for (int i = 0; i < 2; ++i) { const int id = tid + 512 * i, vrow = id >> 3, cc = id & 7;
                *(LAS u32x4*)(lds + 2 * KBYTES + vb * VBYTES + vrow * VST + cc * 16) = vreg[i]; }
        };
        f32x16 Sc;
        auto step = [&](const LAS unsigned char* Kn, const LAS unsigned char* Vb, const LAS int* kpl, int j) {
            if constexpr (DIFF) {
                if (((j < 64 ? nearA >> j : nearB >> (j - 64)) & 1ull) != 0) {
                    const LAS int* kpp = kpl + 4 * h;
#pragma unroll
                    for (int i = 0; i < 16; ++i) { int d0 = qpos - kpp[(i & 3) + 8 * (i >> 2)]; d0 = d0 < 0 ? 0 : (d0 > 255 ? 255 : d0); Sc[i] += lut[d0]; }
                }
            }
            if (j == jlast) {
                int r_ = r - 4 * h; asm volatile("" : "+v"(r_));
#pragma unroll
                for (int i = 0; i < 16; ++i) if ((i & 3) + 8 * (i >> 2) > r_) Sc[i] = -1e30f;
            }
            f32x16 Nx;
#pragma unroll
            for (int i = 0; i < 16; ++i) Nx[i] = 0.f;
#pragma unroll
            for (int ks = 0; ks < NKS; ++ks) { const bf16x8 a0 = *(const LAS bf16x8*)(Kn + r * KST + ks * 32 + h * 16); Nx = MFMA32(a0, qf[ks], Nx); }
            bf16x8 vf0, vf1, vf2, vf3, vf4, vf5, vf6, vf7;
            if constexpr (false) {
                const unsigned va = (unsigned)(size_t)Vb + (unsigned)(r * VST + h * 16);
                asm volatile("ds_read_b128 %0, %8\n\tds_read_b128 %1, %8 offset:32\n\tds_read_b128 %2, %8 offset:4608\n\tds_read_b128 %3, %8 offset:4640\n\t"
                             "ds_read_b128 %4, %8 offset:9216\n\tds_read_b128 %5, %8 offset:9248\n\tds_read_b128 %6, %8 offset:13824\n\tds_read_b128 %7, %8 offset:13856"
                             : "=&v"(vf0), "=&v"(vf1), "=&v"(vf2), "=&v"(vf3), "=&v"(vf4), "=&v"(vf5), "=&v"(vf6), "=&v"(vf7) : "v"(va) : "memory");
            }
            float mxr = 0.f;
            if (!(pvar & 2)) {
            float mx = Sc[0];
#pragma unroll
            for (int i = 1; i < 16; ++i) mx = fmaxf(mx, Sc[i]);
            mx = fmaxf(mx, shx(mx, 32, lane));
            mxr = mx - mrun;
            float ps = 0.f;
#pragma unroll
            for (int i = 0; i < 16; ++i) { Sc[i] = __builtin_amdgcn_exp2f(Sc[i] - mrun); ps += Sc[i]; }
            lrun += ps;
            }
            const bf16x8 p0 = pack8<0>(Sc), p1 = pack8<1>(Sc);
            if constexpr (false) {
                asm volatile("s_waitcnt lgkmcnt(0)" : "+v"(vf0), "+v"(vf1), "+v"(vf2), "+v"(vf3), "+v"(vf4), "+v"(vf5), "+v"(vf6), "+v"(vf7) :: "memory");
                O[0] = MFMA32(vf0, p0, O[0]); O[1] = MFMA32(vf2, p0, O[1]); O[2] = MFMA32(vf4, p0, O[2]); O[3] = MFMA32(vf6, p0, O[3]);
                O[0] = MFMA32(vf1, p1, O[0]); O[1] = MFMA32(vf3, p1, O[1]); O[2] = MFMA32(vf5, p1, O[2]); O[3] = MFMA32(vf7, p1, O[3]);
            } else {
#pragma unroll
                for (int v = 0; v < 4; ++v) {
                    const LAS unsigned char* vp = Vb + (v * 32 + r) * VST + h * 16;
                    O[v] = MFMA32(*(const LAS bf16x8*)vp, p0, O[v]);
                    O[v] = MFMA32(*(const LAS bf16x8*)(vp + 32), p1, O[v]);
                }
            }
            if (j == 0 || __builtin_amdgcn_ballot_w64(mxr > 8.0f) != 0) {
                const float dlt = (j == 0) ? mxr : fmaxf(mxr, 0.f), alpha = __builtin_amdgcn_exp2f(-dlt);
                mrun += dlt; lrun *= alpha;
#pragma unroll
                for (int v = 0; v < 4; ++v)
#pragma unroll
                    for (int i = 0; i < 16; ++i) O[v][i] *= alpha;
            }
            Sc = Nx;
        };
        load_tile(0);
        __syncthreads();
        if constexpr (DIFF) {
            if (c == 0 && tid < 256) {
                const int n = tid; int bk;
                if (n < 16) bk = n; else { const float lr = logf((float)n / 16.0f) / 2.0794415416798357f; bk = 16 + (int)(lr * 16.0f); bk = bk > 31 ? 31 : bk; }
                lut[n] = (a.rel[bk * 8 + head] - a.rel[31 * 8 + head]) * LOG2E;
            }
        }
        store_tile(0, 0);
        __syncthreads();
        if (nt > 1) load_tile(1);
        int vcur = 0, vprev = 2, vnxt = 1;
        for (int t = 0; t <= nt; ++t) {
            if (!(pvar & 1)) { if (t + 1 < nt) store_tile((t + 1) & 1, vnxt);
            if (t + 2 < nt) load_tile(t + 2); }
            SCHED_B;
            const LAS unsigned char* Kt = lds + (t & 1) * KBYTES;
            if (t == 0) {
#pragma unroll
                for (int i = 0; i < 16; ++i) Sc[i] = 0.f;
#pragma unroll
                for (int ks = 0; ks < NKS; ++ks) { const bf16x8 a0 = *(const LAS bf16x8*)(Kt + r * KST + ks * 32 + h * 16); Sc = MFMA32(a0, qf[ks], Sc); }
            } else if (2 * t - 1 <= jlast) {
                step(Kt, lds + 2 * KBYTES + vprev * VBYTES + 64, kposl + vprev * 64 + 32, 2 * t - 1);
            }
            if (t < nt && 2 * t <= jlast) step(Kt + 32 * KST, lds + 2 * KBYTES + vcur * VBYTES, kposl + vcur * 64, 2 * t);
            SCHED_B;
            if (!(pvar & 4)) { asm volatile("s_waitcnt lgkmcnt(0)" ::: "memory"); __builtin_amdgcn_s_barrier(); asm volatile("" ::: "memory"); }
            vprev = vcur; vcur = vnxt; vnxt = (vnxt == 2) ? 0 : vnxt + 1;
        }
        lrun += shx(lrun, 32, lane);
        const float inv = 1.0f / lrun;
        if constexpr (DIFF) {
            const int lane = lane_asm(), h = lane >> 5;
            LAS unsigned* stash = (LAS unsigned*)(lds + 73728 + wid * 8192) + lane;
            if (c == 0) {
#pragma unroll
                for (int v = 0; v < 4; ++v)
#pragma unroll
                    for (int i = 0; i < 8; ++i) stash[(v * 8 + i) * 64] = pk2(O[v][2 * i] * inv, O[v][2 * i + 1] * inv);
            } else {
                float sq = 0.f;
#pragma unroll
                for (int v = 0; v < 4; ++v)
#pragma unroll
                    for (int i = 0; i < 8; ++i) { const unsigned w = stash[(v * 8 + i) * 64];
                        O[v][2 * i] = bf_lo(w) - lam * (O[v][2 * i] * inv); O[v][2 * i + 1] = bf_hi(w) - lam * (O[v][2 * i + 1] * inv);
                        sq += O[v][2 * i] * O[v][2 * i] + O[v][2 * i + 1] * O[v][2 * i + 1]; if ((i & 3) == 3) SCHED_B; }
                sq += shx(sq, 32, lane);
                const float rn = rsq(sq * (1.0f / 128.0f) + EPS) * (1.0f - a.lam_init);
#pragma unroll
                for (int v = 0; v < 4; ++v)
#pragma unroll
                    for (int g = 0; g < 4; ++g) { const f32x4 sg = *(const f32x4*)(a.subg + v * 32 + 8 * g + 4 * h);
#pragma unroll
                        for (int j = 0; j < 4; ++j) O[v][4 * g + j] *= rn * sg[j]; SCHED_B; }
            }
        } else {
#pragma unroll
            for (int v = 0; v < 4; ++v)
#pragma unroll
                for (int i = 0; i < 16; ++i) O[v][i] *= inv;
        }
    }
    {
        const int lane = lane_asm(), r = lane & 31, h = lane >> 5;
        LAS unsigned char* st = lds + wid * (32 * 272);
#pragma unroll
        for (int v = 0; v < 4; ++v)
#pragma unroll
            for (int g = 0; g < 4; ++g) { u32x2 w; w.x = pk2(O[v][4 * g], O[v][4 * g + 1]); w.y = pk2(O[v][4 * g + 2], O[v][4 * g + 3]); *(LAS u32x2*)(st + r * 272 + (v * 32 + 8 * g + 4 * h) * 2) = w; }
        asm volatile("s_waitcnt lgkmcnt(0)" ::: "memory");
        constexpr int OP = DIFF ? 1024 : 2048;
        if (!a.dry)
#pragma unroll
        for (int k = 0; k < 8; ++k) { const int id = lane + 64 * k, row = id >> 4, cc = id & 15;
            const u32x4 w = *(const LAS u32x4*)(st + row * 272 + cc * 16);
            *(u32x4*)(a.O + ((size_t)b * S + qw + row) * OP + head * 128 + cc * 8) = w; }
    }
}

template <bool DIFF>
DI void attn_phase(const AttnArgs& a, LAS unsigned char* lds, const int wid) {
    constexpr int BH = DIFF ? 32 : 64, NU = BH * 16, NHD = DIFF ? 8 : 16;
    const int G = gridDim.x, c = blockIdx.x;
    for (int k = 0;; ++k) {
        const long base = (long)k * G; if (base >= NU) break;
        const long ul = (k & 1) ? base + (G - 1 - c) : base + c;
        if (ul >= NU) continue;
        const int u = (int)ul, qb = 15 - u / BH, bh = u % BH;
        attn_unit<DIFF>(a, lds, bh / NHD, bh % NHD, qb, wid);
    }
    __syncthreads();
}

DI int wmap(int mode, int n0) {
    if (mode == 1) { const int tile = n0 >> 8, p = n0 & 255; return tile * 256 + ((p >> 5) & 3) * 64 + (p >> 7) * 32; }
    if (mode == 2) { const int tile = n0 >> 8, p = n0 & 255; return (p >> 7) * DFF + tile * 128 + (p & 127); }
    if (mode == 3) { if (n0 < 2048) return 192 * (n0 >> 7) + (n0 & 127); const int q = n0 - 2048, tile = q >> 8, p = q & 255; return 192 * (tile * 4 + ((p >> 5) & 3)) + 128 + 32 * (p >> 7); }
    return n0;
}
DI void convert_w(const float* W, int K, int Nsrc, const float* gain, bf16_t* dst, int ndst, int mode, LAS float* scr, int gw, int NGW, int& rot) {
    const int lane = lane_asm();
    if (ndst % 64 == 0) {
        const int nblk = ndst / 64, items = (K / 32) * nblk;
        int first = gw - rot; if (first < 0) first += NGW;
        rot = (rot + items) % NGW;
        for (int it = first; it < items; it += NGW) {
            const int kb = it / nblk, nb = it % nblk, k0 = 32 * kb, n0 = 64 * nb, sc = wmap(mode, n0 + (lane & 32)) + (lane & 31);
            float wv[32];
#pragma unroll
            for (int i = 0; i < 32; ++i) wv[i] = W[(size_t)(k0 + i) * Nsrc + sc];
            if (gain) {
#pragma unroll
                for (int i = 0; i < 32; ++i) wv[i] *= gain[k0 + i];
            }
#pragma unroll
            for (int i = 0; i < 32; ++i) scr[i * 65 + lane] = wv[i];
            asm volatile("s_waitcnt lgkmcnt(0)" ::: "memory");
            const int c4 = lane & 3;
#pragma unroll
            for (int j = 0; j < 4; ++j) { const int n = (lane >> 2) + 16 * j; const LAS float* sp = scr + (8 * c4) * 65 + n;
                u32x4 o; o.x = pk2(sp[0 * 65], sp[1 * 65]); o.y = pk2(sp[2 * 65], sp[3 * 65]); o.z = pk2(sp[4 * 65], sp[5 * 65]); o.w = pk2(sp[6 * 65], sp[7 * 65]);
                *(u32x4*)(dst + (size_t)(n0 + n) * K + k0 + 8 * c4) = o; }
            asm volatile("s_waitcnt lgkmcnt(0)" ::: "memory");
        }
        return;
    }
    const int nblk = ndst / 32, items = (K / 64) * nblk;
    int first = gw - rot; if (first < 0) first += NGW;
    rot = (rot + items) % NGW;
    for (int it = first; it < items; it += NGW) {
        const int kb = it / nblk, nb = it % nblk, k0 = 64 * kb, n0 = 32 * nb, sc0 = wmap(mode, n0);
        float wv[32];
#pragma unroll
        for (int i = 0; i < 32; ++i) { const int kk = 2 * i + (lane >> 5); wv[i] = W[(size_t)(k0 + kk) * Nsrc + sc0 + (lane & 31)]; }
        if (gain) {
#pragma unroll
            for (int i = 0; i < 32; ++i) wv[i] *= gain[k0 + 2 * i + (lane >> 5)];
        }
#pragma unroll
        for (int i = 0; i < 32; ++i) { const int kk = 2 * i + (lane >> 5); scr[kk * 33 + (lane & 31)] = wv[i]; }
        asm volatile("s_waitcnt lgkmcnt(0)" ::: "memory");
        const int c8 = lane & 7;
#pragma unroll
        for (int j = 0; j < 4; ++j) { const int n = (lane >> 3) + 8 * j; const LAS float* s = scr + (8 * c8) * 33 + n;
            u32x4 o; o.x = pk2(s[0 * 33], s[1 * 33]); o.y = pk2(s[2 * 33], s[3 * 33]); o.z = pk2(s[4 * 33], s[5 * 33]); o.w = pk2(s[6 * 33], s[7 * 33]);
            *(u32x4*)(dst + (size_t)(n0 + n) * K + k0 + 8 * c8) = o; }
        asm volatile("s_waitcnt lgkmcnt(0)" ::: "memory");
    }
}

DI void norm128_inplace(bf16_t* buf, const float* ss, int ss_stride, const float* gain, float scale, int gw, int NGW, bool dry = false) {
    const int ln = lane_asm();
    const long total = (long)T * 16 * 16;
    for (long base = (long)gw * 512; base < total; base += (long)NGW * 512) {
        u32x4 w[8]; float rs[8];
#pragma unroll
        for (int k = 0; k < 8; ++k) { const long id = base + k * 64 + ln; w[k] = *(const u32x4*)(buf + id * 8); rs[k] = sum4(ss + (id >> 4) * ss_stride); }
#pragma unroll
        for (int k = 0; k < 8; ++k) {
            const long id = base + k * 64 + ln; const int c8 = (int)(id & 15) * 8;
            const float r = rsq(rs[k] * (1.0f / 128.0f) + EPS) * scale;
            const f32x4 g0 = *(const f32x4*)(gain + c8), g1 = *(const f32x4*)(gain + c8 + 4);
            u32x4 o; o.x = pk2(bf_lo(w[k].x) * g0[0] * r, bf_hi(w[k].x) * g0[1] * r); o.y = pk2(bf_lo(w[k].y) * g0[2] * r, bf_hi(w[k].y) * g0[3] * r);
            o.z = pk2(bf_lo(w[k].z) * g1[0] * r, bf_hi(w[k].z) * g1[1] * r); o.w = pk2(bf_lo(w[k].w) * g1[2] * r, bf_hi(w[k].w) * g1[3] * r);
            *(u32x4*)(buf + id * 8) = dry ? w[k] : o;
        }
    }
}
DI void qpe_inplace(bf16_t* Qp, const float* ss_q, const float* gain, const f32x2* cstab, float scale, long g0, long NGT, bool dry = false) {
    for (long th = g0; th < (long)T * 16; th += NGT) {
        const long tk = th >> 4;
        u32x4 w[8];
#pragma unroll
        for (int k = 0; k < 8; ++k) w[k] = *(const u32x4*)(Qp + th * 64 + k * 8);
        const float r = rsq((ss_q[th * 8 + 4] + ss_q[th * 8 + 5]) * (1.0f / 64.0f) + EPS) * scale;
#pragma unroll
        for (int k = 0; k < 4; ++k) {
            float x1[8], x2[8], y1[8], y2[8];
            x1[0] = bf_lo(w[k].x); x1[1] = bf_hi(w[k].x); x1[2] = bf_lo(w[k].y); x1[3] = bf_hi(w[k].y); x1[4] = bf_lo(w[k].z); x1[5] = bf_hi(w[k].z); x1[6] = bf_lo(w[k].w); x1[7] = bf_hi(w[k].w);
            x2[0] = bf_lo(w[k + 4].x); x2[1] = bf_hi(w[k + 4].x); x2[2] = bf_lo(w[k + 4].y); x2[3] = bf_hi(w[k + 4].y); x2[4] = bf_lo(w[k + 4].z); x2[5] = bf_hi(w[k + 4].z); x2[6] = bf_lo(w[k + 4].w); x2[7] = bf_hi(w[k + 4].w);
#pragma unroll
            for (int j = 0; j < 8; j += 2) {
                const f32x4 cs2 = *(const f32x4*)(cstab + tk * 32 + k * 8 + j);
                const f32x2 ga = *(const f32x2*)(gain + k * 8 + j), gb = *(const f32x2*)(gain + 32 + k * 8 + j);
                const float u1a = x1[j] * ga.x * r, u2a = x2[j] * gb.x * r, u1b = x1[j + 1] * ga.y * r, u2b = x2[j + 1] * gb.y * r;
                y1[j] = u1a * cs2[0] - u2a * cs2[1]; y2[j] = u1a * cs2[1] + u2a * cs2[0];
                y1[j + 1] = u1b * cs2[2] - u2b * cs2[3]; y2[j + 1] = u1b * cs2[3] + u2b * cs2[2];
            }
            u32x4 o1, o2;
            o1.x = pk2(y1[0], y1[1]); o1.y = pk2(y1[2], y1[3]); o1.z = pk2(y1[4], y1[5]); o1.w = pk2(y1[6], y1[7]);
            o2.x = pk2(y2[0], y2[1]); o2.y = pk2(y2[2], y2[3]); o2.z = pk2(y2[4], y2[5]); o2.w = pk2(y2[6], y2[7]);
            *(u32x4*)(Qp + th * 64 + k * 8) = dry ? w[k] : o1; *(u32x4*)(Qp + th * 64 + 32 + k * 8) = dry ? w[k + 4] : o2;
        }
    }
}

#define XB_TMO      128
#define XB_XCNT(j)  (256  + 64 * (j))
#define XB_XSUB(j)  (1280 + 64 * (j))
#define XB_XGEN(j)  (2304 + 64 * (j))
#define XB_TOP      3328
#define XB_TOPGEN   3392
#define XCD_BAR_WORDS 3456
#define XB_SPIN_CAP (1u << 18)

__device__ __forceinline__ unsigned xb_ld(unsigned* p)              { return __hip_atomic_load(p, __ATOMIC_RELAXED, __HIP_MEMORY_SCOPE_AGENT); }
__device__ __forceinline__ unsigned xb_add(unsigned* p, unsigned v) { return __hip_atomic_fetch_add(p, v, __ATOMIC_RELAXED, __HIP_MEMORY_SCOPE_AGENT); }
__device__ __forceinline__ unsigned xb_xcc_id() { return (unsigned)__builtin_amdgcn_s_getreg((3 << 11) | 20) & 0xFu; }
#define XB_SPIN(cond, bar) do { unsigned _sp = 0; while (cond) { __builtin_amdgcn_s_sleep(1); \
    if ((++_sp & 255u) == 0u) { if (xb_ld(&(bar)[XB_TMO])) break; if (_sp > XB_SPIN_CAP) { atomicAdd(&(bar)[XB_TMO], 1u); break; } } } } while (0)

struct XcdBarrier {
    unsigned* bar; unsigned x;
    volatile LAS unsigned* st;
};

__device__ __forceinline__ XcdBarrier xcd_barrier_post(unsigned* bar, volatile LAS unsigned* st, const int xb_wid) {
    XcdBarrier b; b.bar = bar; b.x = xb_xcc_id(); b.st = st;
    if ((xb_wid == 0 && lane_asm() == 0)) (void)xb_add(&bar[XB_XCNT(b.x)], 1u);
    return b;
}
__device__ __forceinline__ void xcd_barrier_complete(unsigned* bar, unsigned x, unsigned& nloc, unsigned& nx) {
    const unsigned G = gridDim.x * gridDim.y * gridDim.z;
    unsigned sum, cnt, mine, sp = 0u;
    for (;;) {
        sum = 0u; cnt = 0u; mine = 0u;
#pragma unroll
        for (unsigned j = 0; j < 16; ++j) { const unsigned c = xb_ld(&bar[XB_XCNT(j)]); sum += c; cnt += (c > 0u) ? 1u : 0u; mine = (j == x) ? c : mine; }
        if (sum == G) break;
        __builtin_amdgcn_s_sleep(1);
        if ((++sp & 255u) == 0u) { if (xb_ld(&bar[XB_TMO])) break; if (sp > XB_SPIN_CAP) { atomicAdd(&bar[XB_TMO], 1u); break; } }
    }
    nloc = mine > 0u ? mine : 1u; nx = cnt > 0u ? cnt : 1u;
}

__device__ __forceinline__ void xcd_barrier(const XcdBarrier& b, const int xb_wid) {
    asm volatile("s_waitcnt vmcnt(0)" ::: "memory");
    __syncthreads();
    if ((xb_wid == 0 && lane_asm() == 0)) {
        unsigned* bar = b.bar;
        __builtin_amdgcn_s_waitcnt(0);
        unsigned nloc = b.st[0], nx = b.st[1];
        if (nloc == 0u) { xcd_barrier_complete(bar, b.x, nloc, nx); b.st[0] = nloc; b.st[1] = nx; }
        const unsigned old = xb_add(&bar[XB_XSUB(b.x)], 1u);
        const unsigned gen = old / nloc;
        if (old + 1u == (gen + 1u) * nloc) {
            __builtin_amdgcn_fence(__ATOMIC_RELEASE, "agent");
            asm volatile("s_waitcnt vmcnt(0)" ::: "memory");
            const unsigned og = xb_add(&bar[XB_TOP], 1u);
            const unsigned tg = og / nx;
            if (og + 1u == (tg + 1u) * nx) xb_add(&bar[XB_TOPGEN], 1u);
            else XB_SPIN(xb_ld(&bar[XB_TOPGEN]) == tg, bar);
            __builtin_amdgcn_fence(__ATOMIC_ACQUIRE, "agent");
            xb_add(&bar[XB_XGEN(b.x)], 1u);
            asm volatile("s_waitcnt vmcnt(0)" ::: "memory");
        } else {
            XB_SPIN(xb_ld(&bar[XB_XGEN(b.x)]) == gen, bar);
            __builtin_amdgcn_fence(__ATOMIC_ACQUIRE, "agent");
            asm volatile("s_waitcnt vmcnt(0)" ::: "memory");
        }
    }
    __syncthreads();
}

struct Args { const void* in[34]; float* out; unsigned char* ws; long probe; };

__global__ void __launch_bounds__(512, 2) fwd_kernel(Args args) {
    extern __shared__ __attribute__((aligned(16))) unsigned char lds_raw[];
    LAS unsigned char* lds = (LAS unsigned char*)lds_raw;
    cg::grid_group grid = cg::this_grid();
    const int wid = __builtin_amdgcn_readfirstlane(threadIdx.x >> 6);
    const int G = gridDim.x, gw = blockIdx.x * 8 + wid, NGW = G * 8;
    const long NGT = (long)G * 512;
#define ltid() (wid * 64 + lane_asm())
#define gtid ((long)blockIdx.x * 512 + ltid())
#define NREP(bit) (1 + ((PROBE_BITS >> (bit)) & 1))
#define PDRY(c) ((c) && KARGS()->probe != 0)
    unsigned char* ws = args.ws;
    float* ssb = (float*)(ws + WS_SS);
    bf16_t* PB = (bf16_t*)(ws + WS_PB);
    bf16_t* WATT = (bf16_t*)(ws + WS_WATT);
    bf16_t* WFFN = (bf16_t*)(ws + WS_WFFN);
    bf16_t* X = (bf16_t*)(ws + WS_X);
    bf16_t* Y = (bf16_t*)(ws + WS_Y);
    bf16_t* R3 = (bf16_t*)(ws + WS_R3);
    bf16_t* R4 = (bf16_t*)(ws + WS_R4);
    LAS float* scr = (LAS float*)(lds + wid * 16384);
    f32x2* cstab = (f32x2*)(ws + WS_CS);
    int* pmaxb = (int*)(ws + WS_SS + 4 * MiB);
#define XIN INF(0)
#define PIN INF(1)
#define POSIN ((const int*)INF(2))
    typedef const Args __attribute__((address_space(4)))* KArgsP;
#define KARGS() ({ KArgsP kp_ = (KArgsP)__builtin_amdgcn_kernarg_segment_ptr(); asm volatile("" : "+s"(kp_)); kp_; })
#define INF(i) ((const float*)KARGS()->in[i])
    float* hout = args.out;
    { volatile LAS unsigned* st0 = (volatile LAS unsigned*)(lds + BARST_OFF); { const int l0 = lane_asm(); if (wid == 0 && l0 < 2) st0[l0] = 0u; } __syncthreads(); }
    const XcdBarrier xbar = xcd_barrier_post((unsigned*)(ws + WS_CTL), (volatile LAS unsigned*)(lds + BARST_OFF), wid);
#define GSYNC() do { xcd_barrier(xbar, wid); if (PROBE_BITS & 4) xcd_barrier(xbar, wid); } while (0)
    bf16_t* Wqkv_t = WATT; bf16_t* WoA_t = WATT + 3 * MiB;
    bf16_t* Wdq_t = WATT; bf16_t* Wuq_t = WATT + 1 * MiB; bf16_t* WoB_t = WATT + (5 * MiB) / 2; bf16_t* Wukv_t = WATT + (9 * MiB) / 2;
    bf16_t* Win_t = WFFN; bf16_t* Wout_t = WFFN + (11 * MiB) / 2; bf16_t* Wg_t = WFFN + (33 * MiB) / 4; bf16_t* Wp_t = WFFN + (37 * MiB) / 4;

    auto conv_attn = [&](int layer) {
        int rot = 0;
        if (layer < 2) {
            convert_w(INF(5) + (size_t)layer * 1024 * 3072, 1024, 3072, INF(4) + layer * 1024, Wqkv_t, 3072, 1, scr, gw, NGW, rot);
            convert_w(INF(13) + (size_t)layer * 1024 * 1024, 1024, 1024, nullptr, WoA_t, 1024, 0, scr, gw, NGW, rot);
        } else {
            const int j = layer - 2;
            convert_w(INF(20) + (size_t)j * 1024 * 512, 1024, 512, INF(4) + layer * 1024, Wdq_t, 512, 0, scr, gw, NGW, rot);
            if (j == 0) {
                convert_w(INF(15), 1024, 320, INF(14), Wdq_t + 512 * 1024, 256, 0, scr, gw, NGW, rot);
                convert_w(INF(15) + 256, 1024, 320, INF(14), Wdq_t + 768 * 1024, 32, 0, scr, gw, NGW, rot);
                convert_w(INF(15) + 288, 1024, 320, INF(14), Wdq_t + 896 * 1024, 32, 0, scr, gw, NGW, rot);
                convert_w(INF(17), 256, 4096, INF(16), Wukv_t, 4096, 0, scr, gw, NGW, rot);
            }
            convert_w(INF(22) + (size_t)j * 512 * 3072, 512, 3072, INF(21) + j * 512, Wuq_t, 3072, 3, scr, gw, NGW, rot);
            convert_w(INF(25) + (size_t)j * 2048 * 1024, 2048, 1024, nullptr, WoB_t, 1024, 0, scr, gw, NGW, rot);
        }
    };
    auto conv_ffn = [&](int layer) {
        int rot = 0;
        convert_w(INF(27) + (size_t)layer * 1024 * 5632, 1024, 5632, INF(26) + layer * 1024, Win_t, 5632, 2, scr, gw, NGW, rot);
        convert_w(INF(30) + (size_t)layer * DFF * 1024, DFF, 1024, nullptr, Wout_t, 1024, 0, scr, gw, NGW, rot);
        convert_w(INF(33) + (size_t)layer * 1024 * 1024, 1024, 1024, INF(31) + layer * 1024, Wg_t, 1024, 0, scr, gw, NGW, rot);
        convert_w(INF(32) + (size_t)layer * 256 * 1024, 256, 1024, nullptr, Wp_t, 1024, 0, scr, gw, NGW, rot);
        const float* pi = PIN + (size_t)layer * T * 256;
        {
            const long i0 = (long)blockIdx.x * 512 + ltid();
            for (long ib = i0; ib < (long)T * 256 / 8; ib += 4 * NGT) {
                f32x4 va[4], vb[4];
#pragma unroll
                for (int k = 0; k < 4; ++k) { const long i = ib + k * NGT; if (i < (long)T * 256 / 8) { va[k] = *(const f32x4*)(pi + i * 8); vb[k] = *(const f32x4*)(pi + i * 8 + 4); } }
#pragma unroll
                for (int k = 0; k < 4; ++k) { const long i = ib + k * NGT; if (i < (long)T * 256 / 8) {
                    u32x4 o; o.x = pk2(va[k][0], va[k][1]); o.y = pk2(va[k][2], va[k][3]); o.z = pk2(vb[k][0], vb[k][1]); o.w = pk2(vb[k][2], vb[k][3]);
                    *(u32x4*)(PB + i * 8) = o; } }
            }
        }
    };

    conv_attn(0);
    for (long i = gtid; i < 512; i += NGT) {
        typedef int i32x4 __attribute__((ext_vector_type(4)));
        const i32x4* pp_ = (const i32x4*)(POSIN + i * 32); i32x4 q_[8]; int mxp;
#pragma unroll
        for (int k = 0; k < 8; ++k) q_[k] = pp_[k];
        mxp = q_[0][0];
#pragma unroll
        for (int k = 0; k < 8; ++k)
#pragma unroll
            for (int e = 0; e < 4; ++e) mxp = q_[k][e] > mxp ? q_[k][e] : mxp;
        pmaxb[i] = mxp;
    }
    for (long i = gtid; i < (long)T * 32; i += NGT) {
        const int d = (int)(i & 31);
        const float ang = (float)POSIN[i >> 5] * expf(-9.210340371976184f * (float)d * (2.0f / 64.0f));
        float sn, cs; sincosf(ang, &sn, &cs);
        cstab[i] = (f32x2){cs, sn};
    }
    for (int m = gw; m < T; m += NGW) {
        const int ln = lane_asm();
        const f32x4* xr = (const f32x4*)(XIN + (size_t)m * D) + ln; float sq = 0.f; f32x4 v[4];
#pragma unroll
        for (int j = 0; j < 4; ++j) { v[j] = xr[64 * j]; sq += dot4(v[j]); }
        sq = wave_sum(sq, ln); if (ln < 16) ssb[(size_t)m * 16 + ln] = (ln == 0) ? sq : 0.f;
#pragma unroll
        for (int j = 0; j < 4; ++j) store_bf4(X + (size_t)m * D + 4 * ln + 256 * j, v[j]);
    }
    grid.sync();

    for (int layer = 0; layer < 4; ++layer) {
        bf16_t* IN = (layer & 1) ? Y : X; bf16_t* OT = (layer & 1) ? X : Y;
        float* ss_in = ssb + (size_t)SS_IN * T;
        float* ss_h1 = ssb + (size_t)SS_H1 * T;
        float* ss_h2 = ssb + (size_t)SS_H2 * T;
        bf16_t* Obuf; const bf16_t* WoT; int Ko;
        if (layer < 2) {
            bf16_t* QA = R3; bf16_t* KA = R3 + 16 * MiB; bf16_t* VtA = R3 + 32 * MiB;
            {
                pg8::Gemm g{IN, Wqkv_t, 1024, 0}; pg8::StaticOrder So; So.init(64, 12, G, blockIdx.x);
                EpiQkvA E{ss_in, INF(6) + layer * 64, INF(7) + layer * 64, QA, KA, VtA};

#ifndef NO_QKVA
                pg8::gemm_phase<EpiQkvA, false>(lds, g, So, E, wid, NREP(4), PROBE_BITS ? KARGS()->probe : 0);
#endif

            }
            GSYNC();
            {
                for (int rep = 0; rep < NREP(11); ++rep) conv_ffn(layer);
                AttnArgs a{}; a.Q = QA; a.K = KA; a.Vt = VtA; a.O = QA; a.pos = POSIN; a.rel = INF(3); a.pmax = pmaxb;
                a.lq1 = INF(8) + layer * 64; a.lk1 = INF(9) + layer * 64; a.lq2 = INF(10) + layer * 64; a.lk2 = INF(11) + layer * 64; a.subg = INF(12) + layer * 128;
                a.lam_init = (layer == 0) ? 0.2f : 0.35550906759096926f;

#ifndef NO_ATTN_DIFF
                { const int nrep = NREP(0); for (int rep = 0; rep < nrep; ++rep) { a.dry = PDRY(rep < nrep - 1) ? (1 | (int)((KARGS()->probe >> 14) & 7) << 1) : 0; attn_phase<true>(a, lds, wid); } }
#endif

            }
            GSYNC();
            Obuf = QA; WoT = WoA_t; Ko = 1024;
        } else {
            const int j = layer - 2;
            bf16_t* Kn = R3; bf16_t* VtB = R3 + 32 * MiB; bf16_t* Kpe = R3 + 64 * MiB;
            bf16_t* Qn = R4; bf16_t* Qp = R4 + 32 * MiB;
            bf16_t* cq = OT; bf16_t* ckv = OT + 8 * MiB;
            float* ss_cq = ssb + (size_t)SS_CQ * T; float* ss_ckv = ssb + (size_t)SS_CKV * T;
            {
                pg8::Gemm g{IN, Wdq_t, 1024, 0}; pg8::StaticOrder So; So.init(64, j == 0 ? 4 : 2, G, blockIdx.x);
                EpiDq E{ss_in, cq, ckv, Kpe, INF(19), cstab, ss_cq, ss_ckv};

#ifndef NO_DQ
                pg8::gemm_phase<EpiDq, false>(lds, g, So, E, wid, NREP(9), PROBE_BITS ? KARGS()->probe : 0);
#endif

            }
            GSYNC();
            {
                { pg8::Gemm g{cq, Wuq_t, 512, 0}; pg8::StaticOrder So; So.init(64, 12, G, blockIdx.x); EpiUq E{ss_cq, Qn, Qp, INF(23) + j * 128, INF(24) + j * 64, cstab, (LAS float*)(lds + XCH_OFF)};
#ifndef NO_UQ
 pg8::gemm_phase<EpiUq, true>(lds, g, So, E, wid, NREP(10), PROBE_BITS ? KARGS()->probe : 0);
#endif
 }
                if (j == 0) { pg8::Gemm g{ckv, Wukv_t, 256, 0}; pg8::StaticOrder So; So.init(64, 16, G, blockIdx.x); EpiUkv E{ss_ckv, Kn, VtB, INF(18), (LAS float*)(lds + XCH_OFF)};
#ifndef NO_UKV
 pg8::gemm_phase<EpiUkv, true>(lds, g, So, E, wid, NREP(10), PROBE_BITS ? KARGS()->probe : 0);
#endif
 }
            }
            GSYNC();
            {
                for (int rep = 0; rep < NREP(11); ++rep) conv_ffn(layer);
                AttnArgs a{}; a.Q = Qn; a.Q2 = Qp; a.K = Kn; a.K2 = Kpe; a.Vt = VtB; a.O = Qn; a.pos = POSIN;
                a.gn = INF(23) + j * 128; a.gp = INF(24) + j * 64; a.cs = cstab;

#ifndef NO_ATTN_MLA
                { const int nrep = NREP(1); for (int rep = 0; rep < nrep; ++rep) { a.dry = PDRY(rep < nrep - 1); attn_phase<false>(a, lds, wid); } }
#endif

            }
            GSYNC();
            Obuf = Qn; WoT = WoB_t; Ko = 2048;
        }
        {
            pg8::Gemm g{Obuf, WoT, Ko, 0}; pg8::StaticOrder So; So.init(64, 4, G, blockIdx.x);
            EpiRes E{IN, ss_h1};

#ifndef NO_RES
            pg8::gemm_phase<EpiRes, false>(lds, g, So, E, wid, NREP(5), PROBE_BITS ? KARGS()->probe : 0);
#endif
        }
        GSYNC();
        {
            if (layer < 3) { for (int rep = 0; rep < NREP(11); ++rep) conv_attn(layer + 1); __syncthreads(); }
            pg8::Gemm g{IN, Win_t, 1024, 1}; pg8::StaticOrder So; So.init(68, 22, G, blockIdx.x);
            EpiFfnIn E{ss_h1, INF(28) + (size_t)layer * 3 * 5632, INF(29) + (size_t)layer * 5632, R4, (LAS float*)(lds + XCH_OFF)};

#ifndef NO_FFNIN
            pg8::gemm_phase<EpiFfnIn, true>(lds, g, So, E, wid, NREP(6), PROBE_BITS ? KARGS()->probe : 0);
#endif

        }
        GSYNC();
        {
            { pg8::Gemm g{R4, Wout_t, DFF, 0}; pg8::StaticOrder So; So.init(64, 4, G, blockIdx.x); EpiRes E{IN, ss_h2};
#ifndef NO_RES
 pg8::gemm_phase<EpiRes, false>(lds, g, So, E, wid, NREP(7), PROBE_BITS ? KARGS()->probe : 0);
#endif
 }
            { pg8::Gemm g{PB, Wp_t, 256, 0}; pg8::StaticOrder So; So.init(64, 4, G, blockIdx.x); EpiPlain E{OT};
#ifndef NO_PLAIN
 pg8::gemm_phase<EpiPlain, false>(lds, g, So, E, wid, NREP(7), PROBE_BITS ? KARGS()->probe : 0);
#endif
 }
        }
        GSYNC();
        {
            pg8::Gemm g{IN, Wg_t, 1024, 0}; pg8::StaticOrder So; So.init(64, 4, G, blockIdx.x);
            EpiPle E{IN, OT, layer == 3 ? hout : nullptr, ss_h2, layer < 3 ? ss_in : nullptr};

#ifndef NO_PLE
            pg8::gemm_phase<EpiPle, false>(lds, g, So, E, wid, NREP(8), PROBE_BITS ? KARGS()->probe : 0);
#endif

        }
        if (layer < 3) GSYNC();
    }
}

extern "C" void kernel_launch(void* const* d_in, const int* in_sizes, int n_in, void* d_out, int out_size, void* d_ws, size_t ws_size, hipStream_t stream) {
    static int grid = 0;
    if (grid == 0) {
        if (n_in != 34 || out_size != T * D || ws_size < WS_END) { fprintf(stderr, "kernel_launch: unexpected shapes (n_in %d out %d ws %zu)\n", n_in, out_size, ws_size); grid = -1; return; }
        int dev = 0, cus = 0, per_cu = 0;
        hipGetDevice(&dev); hipDeviceGetAttribute(&cus, hipDeviceAttributeMultiprocessorCount, dev);
        if (hipFuncSetAttribute((const void*)fwd_kernel, hipFuncAttributeMaxDynamicSharedMemorySize, LDS_BYTES) != hipSuccess) { fprintf(stderr, "hipFuncSetAttribute failed\n"); grid = -1; return; }
        hipOccupancyMaxActiveBlocksPerMultiprocessor(&per_cu, (const void*)fwd_kernel, 512, LDS_BYTES);
        if (per_cu < 1) { fprintf(stderr, "occupancy query: %d\n", per_cu); per_cu = 1; }
        grid = cus * 1;
    }
    if (grid < 0) return;
    if (hipMemsetAsync((char*)d_ws + WS_CTL, 0, 16384, stream) != hipSuccess) { fprintf(stderr, "memset failed\n"); return; }
    Args a{};
    for (int i = 0; i < 34; ++i) a.in[i] = d_in[i];
    a.out = (float*)d_out; a.ws = (unsigned char*)d_ws; a.probe = PROBE_BITS;
    void* kargs[] = {&a};
    hipError_t e = hipLaunchCooperativeKernel((const void*)fwd_kernel, dim3(grid), dim3(512), kargs, LDS_BYTES, stream);
    if (e != hipSuccess) fprintf(stderr, "cooperative launch failed: %s (grid %d)\n", hipGetErrorString(e), grid);
}
```

```cpp
#include <hip/hip_runtime.h>
#include <hip/hip_cooperative_groups.h>
#include <cstdio>
#include <cstdint>
namespace cg = cooperative_groups;
#ifndef PROBE_BITS
#define PROBE_BITS 0
#endif

#define LAS __attribute__((address_space(3)))
typedef unsigned short bf16_t;
typedef short bf16x8 __attribute__((ext_vector_type(8)));
typedef short s16x4 __attribute__((ext_vector_type(4)));
typedef float f32x2 __attribute__((ext_vector_type(2)));
typedef float f32x4 __attribute__((ext_vector_type(4)));
typedef float f32x16 __attribute__((ext_vector_type(16)));
typedef unsigned u32x2 __attribute__((ext_vector_type(2)));
typedef unsigned u32x4 __attribute__((ext_vector_type(4)));
typedef __bf16 nbf16x2 __attribute__((ext_vector_type(2)));
#define DI __device__ __forceinline__
#define SCHED_B __builtin_amdgcn_sched_barrier(0)

constexpr int T = 16384, S = 4096, NB = 4, D = 1024;
constexpr int DFF = 2816;
constexpr float EPS = 1e-6f;
constexpr float LOG2E = 1.4426950408889634f;

constexpr size_t MiB = 1u << 20;
constexpr size_t WS_SS = 0;
constexpr size_t WS_CTL = 6 * MiB + 512 * 1024;
constexpr size_t WS_PB = 7 * MiB;
constexpr size_t WS_WATT = 15 * MiB;
constexpr size_t WS_WFFN = 26 * MiB;
constexpr size_t WS_X = 47 * MiB;
constexpr size_t WS_Y = 81 * MiB;
constexpr size_t WS_R3 = 114 * MiB;
constexpr size_t WS_R4 = 244 * MiB;
constexpr size_t WS_CS = 340 * MiB;
constexpr size_t WS_END = 344 * MiB;
constexpr int SS_IN = 0, SS_H1 = 16, SS_H2 = 32, SS_CQ = 48, SS_CKV = 56;

constexpr int RING_BYTES = 131072;
constexpr int XCH_OFF = RING_BYTES;
constexpr int LUT_OFF = RING_BYTES + 8192;
constexpr int KPOS_OFF = LUT_OFF + 1024;
constexpr int BARST_OFF = KPOS_OFF + 1024;
constexpr int LDS_BYTES = 147456;

DI unsigned pk2(float a, float b) { f32x2 v = {a, b}; nbf16x2 r = __builtin_convertvector(v, nbf16x2); return __builtin_bit_cast(unsigned, r); }
DI float bf_lo(unsigned u) { return __builtin_bit_cast(float, u << 16); }
DI float bf_hi(unsigned u) { return __builtin_bit_cast(float, u & 0xffff0000u); }
DI int lane_asm();
DI float shx(float v, int mask, int ln) { return __builtin_bit_cast(float, __builtin_amdgcn_ds_bpermute((ln ^ mask) << 2, __builtin_bit_cast(int, v))); }
DI int shxi(int v, int mask, int ln) { return __builtin_amdgcn_ds_bpermute((ln ^ mask) << 2, v); }
DI float shl(float v, int src) { return __builtin_bit_cast(float, __builtin_amdgcn_ds_bpermute(src << 2, __builtin_bit_cast(int, v))); }
template <int N> DI float dpp_ror(float v) { return __builtin_bit_cast(float, __builtin_amdgcn_update_dpp(0, __builtin_bit_cast(int, v), 0x120 + N, 0xF, 0xF, false)); }
DI float wave_sum(float v, int ln) {
#pragma unroll
    for (int o = 1; o < 64; o <<= 1) v += shx(v, o, ln);
    return v;
}
DI float rsq(float x) { return 1.0f / sqrtf(x); }
DI int lane_asm() { int l; asm volatile("v_mbcnt_lo_u32_b32 %0, -1, 0\n\tv_mbcnt_hi_u32_b32 %0, -1, %0" : "=v"(l)); return l; }

namespace pg8 {
constexpr int BM = 256, BK = 64, HALF = 128, HTB = HALF * BK * 2, NXCD = 8, WGM = 8;
__host__ __device__ __forceinline__ int lds_byte(int r, int c) { const int st = (r >> 4) * 2 + (c >> 5), rr = r & 15, cc = c & 31, ob = rr * 64 + cc * 2; return st * 1024 + (ob ^ (((ob >> 9) & 1) << 5)); }
__host__ __device__ __forceinline__ void stage_rc(int b, int& R, int& C) { const int st = b / 1024, sb = b % 1024, swz = sb ^ (((sb >> 9) & 1) << 5); R = (st >> 1) * 16 + swz / 64; C = (st & 1) * 32 + (swz % 64) / 2; }

__host__ __device__ __forceinline__ int perm32(int rho) { const int n = rho >> 4, i = rho & 15; return 8 * (i >> 2) + 4 * n + (i & 3); }
struct Unit { int pm, pn; };
struct Gemm { const bf16_t* A; const bf16_t* Bt; int K; int ovl; };
DI long a_row0(const Gemm& g, int pm) { return g.ovl ? (long)(pm / 17) * S + 254 * (pm % 17) - 2 : (long)pm * BM; }

struct StaticOrder {
    int nM, nN, nwg, G, c;
    DI void init(int nM_, int nN_, int G_, int c_) { nM = nM_; nN = nN_; nwg = nM * nN; G = G_; c = c_; }
    DI bool next(int i, Unit& u) const {
        const long L = (long)i * G + c; if (L >= nwg) return false;
        int wgid = (int)L; { const int q = nwg / NXCD, r = nwg % NXCD, xcd = wgid % NXCD, off = wgid / NXCD; wgid = (xcd < r ? xcd * (q + 1) : r * (q + 1) + (xcd - r) * q) + off; }
        const int nig = WGM * nN, gid = wgid / nig, fm = gid * WGM, gsz = (nM - fm) < WGM ? (nM - fm) : WGM;
        u.pm = fm + ((wgid % nig) % gsz); u.pn = (wgid % nig) / gsz; return true;
    }
};

template <class Epi, bool ALIGN_EPI>
DI void gemm_phase1(LAS unsigned char* lds, const Gemm g, const StaticOrder& Sd, const Epi& E, const int wid_in, const int dry) {
    int wid = wid_in; asm volatile("" : "+s"(wid));
    const int lane = lane_asm(), tid = wid * 64 + lane;
    const int wr = wid >> 2, wc = wid & 3, fr = lane & 15, fq = lane >> 4;
    int K = g.K; asm volatile("" : "+s"(K));
    const int nt = K / BK;
    unsigned voffA[2], voffB[2];
#pragma unroll
    for (int i = 0; i < 2; ++i) { int R, C; stage_rc(tid * 16 + i * 8192, R, C); const int Rb = Epi::PERM ? ((R & ~31) + perm32(R & 31)) : R; voffB[i] = (unsigned)(Rb * K + C) * 2u;
        const int Ra = g.ovl ? ((R & 64) | ((R & 15) << 2) | ((R >> 4) & 3)) : R;
        voffA[i] = (unsigned)(Ra * K + C) * 2u; }
    const size_t kstep = (size_t)(BK * 2);
    const size_t hstep = (size_t)HALF * K * 2;
    const size_t tstep = 2 * hstep;
    const size_t rowb = (size_t)K * 2;
    const unsigned ldsw = (unsigned)wid * 1024u;
    const int aoff = lds_byte(wr * 64 + fr, fq * 8), boff = lds_byte(wc * 32 + fr, fq * 8);
#define PG8_SA(b, h) (((b) * 2 + (h)) * HTB)
#define PG8_SB(b, h) ((4 + (b) * 2 + (h)) * HTB)
#define PG8_STAGE(bufoff, gbase, voff) do { _Pragma("unroll") for (int _i = 0; _i < 2; ++_i) \
        __builtin_amdgcn_global_load_lds((const unsigned*)((const char*)(gbase) + (voff)[_i]), (LAS unsigned*)(lds + (bufoff) + ldsw + _i * 8192), 16, 0, 0); } while (0)
#define PG8_LDA(dst, b, h) do { _Pragma("unroll") for (int m = 0; m < 4; ++m) _Pragma("unroll") for (int k = 0; k < 2; ++k) dst[m][k] = *(const LAS bf16x8*)(lds + PG8_SA(b, h) + aoff + m * 2048 + k * 1024); } while (0)
#define PG8_LDB(dst, b, h) do { _Pragma("unroll") for (int n = 0; n < 2; ++n) _Pragma("unroll") for (int k = 0; k < 2; ++k) dst[n][k] = *(const LAS bf16x8*)(lds + PG8_SB(b, h) + boff + n * 2048 + k * 1024); } while (0)
#define PG8_MMA(ai, bj, At, Bt) do { __builtin_amdgcn_s_setprio(1); _Pragma("unroll") for (int m = 0; m < 4; ++m) _Pragma("unroll") for (int n = 0; n < 2; ++n) _Pragma("unroll") for (int k = 0; k < 2; ++k) \
        acc[ai][bj][m][n] = __builtin_amdgcn_mfma_f32_16x16x32_bf16(Bt[n][k], At[m][k], acc[ai][bj][m][n], 0, 0, 0); __builtin_amdgcn_s_setprio(0); } while (0)
#define PG8_WAIT_V(n) asm volatile("s_waitcnt vmcnt(" #n ")" ::: "memory")
#define PG8_WAIT_L(n) asm volatile("s_waitcnt lgkmcnt(" #n ")" ::: "memory")
#define PG8_BAR __builtin_amdgcn_s_barrier()
#define PG8_SCHED __builtin_amdgcn_sched_barrier(0)
    Unit cur, nxt; int ui = 0;
    if (!Sd.next(0, cur)) return;
    f32x4 acc[2][2][4][2];
#pragma unroll
    for (int a = 0; a < 2; ++a)
#pragma unroll
        for (int b = 0; b < 2; ++b)
#pragma unroll
            for (int m = 0; m < 4; ++m)
#pragma unroll
                for (int n = 0; n < 2; ++n) acc[a][b][m][n] = (f32x4){0.f, 0.f, 0.f, 0.f};
    bf16x8 At[4][2], B0[2][2], B1[2][2];
    const char* cA = (const char*)g.A + a_row0(g, cur.pm) * (long)rowb; const char* cB = (const char*)g.Bt + (size_t)cur.pn * tstep;
    {
        PG8_STAGE(PG8_SB(0, 0), cB, voffB); PG8_STAGE(PG8_SB(0, 1), cB + hstep, voffB); PG8_STAGE(PG8_SA(0, 0), cA, voffA); PG8_STAGE(PG8_SA(0, 1), cA + hstep, voffA);
        if (wr == 1) PG8_BAR;
        PG8_WAIT_V(2); PG8_BAR;
        PG8_STAGE(PG8_SB(1, 0), cB + kstep, voffB); PG8_STAGE(PG8_SA(1, 0), cA + kstep, voffA); PG8_STAGE(PG8_SB(1, 1), cB + hstep + kstep, voffB);
        PG8_WAIT_V(6); PG8_BAR;
    }
    for (;;) {
        const bool has_next = Sd.next(ui + 1, nxt);
        const char* nA = has_next ? (const char*)g.A + a_row0(g, nxt.pm) * (long)rowb : cA; const char* nB = has_next ? (const char*)g.Bt + (size_t)nxt.pn * tstep : cB;
        for (int t = 0; t < nt; t += 2) {
            const bool last = (t == nt - 2);
            const char* a1 = cA + (size_t)(t + 1) * kstep;
            const char* a2 = last ? nA : cA + (size_t)(t + 2) * kstep; const char* b2 = last ? nB : cB + (size_t)(t + 2) * kstep;
            const char* a3 = a2 + kstep; const char* b3 = b2 + kstep;
            PG8_LDB(B0, 0, 0); PG8_LDB(B1, 0, 1); PG8_SCHED; PG8_LDA(At, 0, 0); PG8_STAGE(PG8_SA(1, 1), a1 + hstep, voffA);
            PG8_WAIT_V(8); PG8_WAIT_L(0); PG8_BAR; PG8_MMA(0, 0, At, B0); PG8_MMA(0, 1, At, B1); PG8_BAR; PG8_SCHED;
            PG8_LDA(At, 0, 1); PG8_STAGE(PG8_SB(0, 0), b2, voffB); PG8_STAGE(PG8_SB(0, 1), b2 + hstep, voffB); PG8_STAGE(PG8_SA(0, 0), a2, voffA);
            PG8_WAIT_V(8); PG8_WAIT_L(0); PG8_BAR; PG8_MMA(1, 0, At, B0); PG8_MMA(1, 1, At, B1); PG8_BAR; PG8_SCHED;
            PG8_LDB(B0, 1, 0); PG8_LDB(B1, 1, 1); PG8_SCHED; PG8_LDA(At, 1, 0); PG8_STAGE(PG8_SA(0, 1), a2 + hstep, voffA);
            PG8_WAIT_V(8); PG8_WAIT_L(0); PG8_BAR; PG8_MMA(0, 0, At, B0); PG8_MMA(0, 1, At, B1); PG8_BAR; PG8_SCHED;
            PG8_LDA(At, 1, 1); PG8_STAGE(PG8_SB(1, 0), b3, voffB); PG8_STAGE(PG8_SB(1, 1), b3 + hstep, voffB); PG8_STAGE(PG8_SA(1, 0), a3, voffA);
            PG8_WAIT_V(8); PG8_WAIT_L(0); PG8_BAR; PG8_MMA(1, 0, At, B0); PG8_MMA(1, 1, At, B1); PG8_BAR; PG8_SCHED;
        }
        if constexpr (ALIGN_EPI) { if (wr == 0) PG8_BAR; }
        { int fr_ = fr, fq_ = fq; asm volatile("" : "+v"(fr_), "+v"(fq_)); E(acc, cur, wr, wc, fr_, fq_, dry != 0); }
        if (!has_next) break;
#pragma unroll
        for (int a = 0; a < 2; ++a)
#pragma unroll
            for (int b = 0; b < 2; ++b)
#pragma unroll
                for (int m = 0; m < 4; ++m)
#pragma unroll
                    for (int n = 0; n < 2; ++n) acc[a][b][m][n] = (f32x4){0.f, 0.f, 0.f, 0.f};
        cur = nxt; cA = nA; cB = nB; ++ui;
        if constexpr (ALIGN_EPI) { if (wr == 1) PG8_BAR; }
    }
    PG8_WAIT_V(0);
    if constexpr (!ALIGN_EPI) { if (wr == 0) PG8_BAR; }
    PG8_BAR;
#undef PG8_SA
#undef PG8_SB
#undef PG8_STAGE
#undef PG8_LDA
#undef PG8_LDB
#undef PG8_MMA
#undef PG8_WAIT_V
#undef PG8_WAIT_L
#undef PG8_BAR
#undef PG8_SCHED
}
template <class Epi, bool ALIGN_EPI>
DI void gemm_phase(LAS unsigned char* lds, const Gemm g, const StaticOrder& Sd, const Epi& E, const int wid, const int nrep = 1, const long pflag = 0) {
    for (int rep = 0; rep < nrep; ++rep) gemm_phase1<Epi, ALIGN_EPI>(lds, g, Sd, E, wid, (rep < nrep - 1) && pflag != 0);
}
}
using pg8::Unit;
typedef f32x4 AccT[2][2][4][2];

DI int vperm16(int k) { return ((k >> 2) & 1) * 8 + (k >> 3) * 4 + (k & 3); }
DI void store_bf4(bf16_t* p, f32x4 v) { u32x2 w; w.x = pk2(v[0], v[1]); w.y = pk2(v[2], v[3]); *(u32x2*)p = w; }
DI float dot4(f32x4 v) { return (v[0] * v[0] + v[1] * v[1]) + (v[2] * v[2] + v[3] * v[3]); }

DI float sum16(const float* p) { const f32x4 a = *(const f32x4*)p, b = *(const f32x4*)(p + 4), c = *(const f32x4*)(p + 8), d = *(const f32x4*)(p + 12);
    return (((a[0] + a[1]) + (a[2] + a[3])) + ((b[0] + b[1]) + (b[2] + b[3]))) + (((c[0] + c[1]) + (c[2] + c[3])) + ((d[0] + d[1]) + (d[2] + d[3]))); }
DI float sum16c(const float* p, int fq, int ln) { const f32x4 a = *(const f32x4*)(p + fq * 4); float t = (a[0] + a[1]) + (a[2] + a[3]); t += shx(t, 16, ln); t += shx(t, 32, ln); return t; }
DI float sum8(const float* p) { const f32x4 a = *(const f32x4*)p, b = *(const f32x4*)(p + 4); return ((a[0] + a[1]) + (a[2] + a[3])) + ((b[0] + b[1]) + (b[2] + b[3])); }
DI float sum4(const float* p) { const f32x4 a = *(const f32x4*)p; return (a[0] + a[1]) + (a[2] + a[3]); }
struct EpiRes {
    static constexpr bool PERM = true;
    bf16_t* hb; float* ss;
    DI void operator()(AccT& acc, const Unit& u, int wr, int wc, int fr, int fq, const bool dry) const {
#pragma unroll
        for (int ai = 0; ai < 2; ++ai)
#pragma unroll
            for (int m = 0; m < 4; ++m) {
                const size_t row = (size_t)u.pm * 256 + ai * 128 + wr * 64 + m * 16 + fr; float sq = 0.f;
#pragma unroll
                for (int bj = 0; bj < 2; ++bj) {
                    const size_t off = row * D + u.pn * 256 + bj * 128 + wc * 32 + fq * 8;
                    const u32x4 hw = *(const u32x4*)(hb + off);
                    const f32x4 v0 = (f32x4){bf_lo(hw.x), bf_hi(hw.x), bf_lo(hw.y), bf_hi(hw.y)} + acc[ai][bj][m][0];
                    const f32x4 v1 = (f32x4){bf_lo(hw.z), bf_hi(hw.z), bf_lo(hw.w), bf_hi(hw.w)} + acc[ai][bj][m][1];
                    u32x4 o; o.x = pk2(v0[0], v0[1]); o.y = pk2(v0[2], v0[3]); o.z = pk2(v1[0], v1[1]); o.w = pk2(v1[2], v1[3]);
                    *(u32x4*)(hb + off) = dry ? hw : o;
                    sq += dot4(v0) + dot4(v1);
                }
                sq += shx(sq, 16, fq * 16 + fr); sq += shx(sq, 32, fq * 16 + fr);
                if (fq == 0 && !dry) ss[row * 16 + u.pn * 4 + wc] = sq;
            }
    }
};
struct EpiPlain {
    static constexpr bool PERM = true;
    bf16_t* out;
    DI void operator()(AccT& acc, const Unit& u, int wr, int wc, int fr, int fq, const bool dry) const {
#pragma unroll
        for (int ai = 0; ai < 2; ++ai)
#pragma unroll
            for (int m = 0; m < 4; ++m) {
                const size_t row = (size_t)u.pm * 256 + ai * 128 + wr * 64 + m * 16 + fr;
#pragma unroll
                for (int bj = 0; bj < 2; ++bj) { const f32x4 v0 = acc[ai][bj][m][0], v1 = acc[ai][bj][m][1];
                    u32x4 o; o.x = pk2(v0[0], v0[1]); o.y = pk2(v0[2], v0[3]); o.z = pk2(v1[0], v1[1]); o.w = pk2(v1[2], v1[3]);
                    *(u32x4*)(out + row * D + u.pn * 256 + bj * 128 + wc * 32 + fq * 8) = o; }
            }
    }
};
struct EpiPle {
    static constexpr bool PERM = true;
    const bf16_t* hin; bf16_t* ot; float* outf; const float* ss_in; float* ss_out;
    DI void operator()(AccT& acc, const Unit& u, int wr, int wc, int fr, int fq, const bool dry) const {
        float rsv[2][4];
#pragma unroll
        for (int ai = 0; ai < 2; ++ai)
#pragma unroll
            for (int m = 0; m < 4; ++m) { const size_t row = (size_t)u.pm * 256 + ai * 128 + wr * 64 + m * 16 + fr; rsv[ai][m] = rsq(sum16c(ss_in + row * 16, fq, fq * 16 + fr) * (1.0f / D) + EPS); }
#pragma unroll
        for (int ai = 0; ai < 2; ++ai)
#pragma unroll
            for (int m = 0; m < 4; ++m) {
                const size_t row = (size_t)u.pm * 256 + ai * 128 + wr * 64 + m * 16 + fr; float sq = 0.f;
                const float rs = rsv[ai][m];
#pragma unroll
                for (int bj = 0; bj < 2; ++bj) {
                    const size_t off = row * D + u.pn * 256 + bj * 128 + wc * 32 + fq * 8;
                    const u32x4 pw = *(const u32x4*)(ot + off), hw = *(const u32x4*)(hin + off);
                    const f32x4 pp0 = {bf_lo(pw.x), bf_hi(pw.x), bf_lo(pw.y), bf_hi(pw.y)}, pp1 = {bf_lo(pw.z), bf_hi(pw.z), bf_lo(pw.w), bf_hi(pw.w)};
                    f32x4 v0 = {bf_lo(hw.x), bf_hi(hw.x), bf_lo(hw.y), bf_hi(hw.y)}, v1 = {bf_lo(hw.z), bf_hi(hw.z), bf_lo(hw.w), bf_hi(hw.w)};
                    const f32x4 g0 = acc[ai][bj][m][0] * rs, g1 = acc[ai][bj][m][1] * rs;
#pragma unroll
                    for (int e = 0; e < 4; ++e) { v0[e] += pp0[e] * __builtin_amdgcn_rcpf(1.0f + __builtin_amdgcn_exp2f(-LOG2E * g0[e])); v1[e] += pp1[e] * __builtin_amdgcn_rcpf(1.0f + __builtin_amdgcn_exp2f(-LOG2E * g1[e])); }
                    if (outf) { if (!dry) { *(f32x4*)(outf + off) = v0; *(f32x4*)(outf + off + 4) = v1; } }
                    else { u32x4 o; o.x = pk2(v0[0], v0[1]); o.y = pk2(v0[2], v0[3]); o.z = pk2(v1[0], v1[1]); o.w = pk2(v1[2], v1[3]); *(u32x4*)(ot + off) = dry ? pw : o; }
                    sq += dot4(v0) + dot4(v1);
                }
                if (ss_out) { sq += shx(sq, 16, fq * 16 + fr); sq += shx(sq, 32, fq * 16 + fr); if (fq == 0 && !dry) ss_out[row * 16 + u.pn * 4 + wc] = sq; }
            }
    }
};
struct EpiQkvA {
    static constexpr bool PERM = true;
    const float* ss_in; const float* qg; const float* kg; bf16_t* Q; bf16_t* Kb; bf16_t* Vt;
    DI void operator()(AccT& acc, const Unit& u, int wr, int wc, int fr, int fq, const bool dry) const {
        const float live = dry ? 0.f : 1.f; (void)live;
        const int L = u.pn * 256 + wc * 64;
        float rsv[2][4];
#pragma unroll
        for (int ai = 0; ai < 2; ++ai)
#pragma unroll
            for (int m = 0; m < 4; ++m) { const size_t row = (size_t)u.pm * 256 + ai * 128 + wr * 64 + m * 16 + fr; rsv[ai][m] = rsq(sum16c(ss_in + row * 16, fq, fq * 16 + fr) * (1.0f / D) + EPS); }
#pragma unroll
        for (int ai = 0; ai < 2; ++ai)
#pragma unroll
            for (int m = 0; m < 4; ++m) {
                const size_t row = (size_t)u.pm * 256 + ai * 128 + wr * 64 + m * 16 + fr;
                const float rs = rsv[ai][m];
                if (u.pn < 8) {
                    float sq = 0.f;
#pragma unroll
                    for (int bj = 0; bj < 2; ++bj)
#pragma unroll
                        for (int n = 0; n < 2; ++n) { acc[ai][bj][m][n] *= rs; sq += dot4(acc[ai][bj][m][n]); }
                    sq += shx(sq, 16, fq * 16 + fr); sq += shx(sq, 32, fq * 16 + fr);
                    float rg = rsq(sq * (1.0f / 64.0f) + EPS);
                    const float* gp = (u.pn < 4) ? qg : kg; if (u.pn < 4) rg *= 0.125f * LOG2E;
                    bf16_t* dst = (u.pn < 4) ? Q + row * 1024 + L : Kb + row * 1024 + (L - 1024);
#pragma unroll
                    for (int bj = 0; bj < 2; ++bj) { const int d = 32 * bj + 8 * fq; const f32x4 g0 = *(const f32x4*)(gp + d), g1 = *(const f32x4*)(gp + d + 4);
                        { const f32x4 a_ = acc[ai][bj][m][0] * g0 * rg, b_ = acc[ai][bj][m][1] * g1 * rg; u32x4 o_; o_.x = pk2(a_[0], a_[1]); o_.y = pk2(a_[2], a_[3]); o_.z = pk2(b_[0], b_[1]); o_.w = pk2(b_[2], b_[3]); *(u32x4*)(dst + d) = o_; } }
                } else {
                    const int b = (int)(row >> 12), s_ = (int)(row & 4095), s = (s_ & ~15) | vperm16(s_ & 15);
#pragma unroll
                    for (int bj = 0; bj < 2; ++bj)
#pragma unroll
                        for (int n = 0; n < 2; ++n) {
                            const int lv = L - 2048 + 32 * bj + 8 * fq + 4 * n;
                            bf16_t* p = Vt + ((size_t)b * 1024 + lv) * S + s;
                            const f32x4 v = acc[ai][bj][m][n] * rs;
                            const unsigned w0 = pk2(v[0], v[1]), w1 = pk2(v[2], v[3]);
                            p[0] = (bf16_t)(w0 & 0xffff); p[S] = (bf16_t)(w0 >> 16); p[2 * S] = (bf16_t)(w1 & 0xffff); p[3 * S] = (bf16_t)(w1 >> 16);
                            SCHED_B;
                        }
                }
                SCHED_B;
            }
    }
};
struct EpiDq {
    static constexpr bool PERM = true;
    const float* ss_in; bf16_t* cq; bf16_t* ckv; bf16_t* Kpe; const float* gpe; const f32x2* cst; float* ss_cq; float* ss_ckv;
    DI void operator()(AccT& acc, const Unit& u, int wr, int wc, int fr, int fq, const bool dry) const {
        float rsv[2][4];
#pragma unroll
        for (int ai = 0; ai < 2; ++ai)
#pragma unroll
            for (int m = 0; m < 4; ++m) { const size_t row = (size_t)u.pm * 256 + ai * 128 + wr * 64 + m * 16 + fr; rsv[ai][m] = rsq(sum16c(ss_in + row * 16, fq, fq * 16 + fr) * (1.0f / D) + EPS); }
#pragma unroll
        for (int ai = 0; ai < 2; ++ai)
#pragma unroll
            for (int m = 0; m < 4; ++m) {
                const size_t row = (size_t)u.pm * 256 + ai * 128 + wr * 64 + m * 16 + fr;
                const float rs = rsv[ai][m]; float sq = 0.f;
                if (u.pn < 3) {
#pragma unroll
                    for (int bj = 0; bj < 2; ++bj) {
                        const int c = bj * 128 + wc * 32 + fq * 8; const f32x4 v0 = acc[ai][bj][m][0] * rs, v1 = acc[ai][bj][m][1] * rs;
                        bf16_t* dp = (u.pn < 2) ? cq + row * 512 + u.pn * 256 + c : ckv + row * 256 + c;
                        { const f32x4 a_ = v0, b_ = v1; u32x4 o_; o_.x = pk2(a_[0], a_[1]); o_.y = pk2(a_[2], a_[3]); o_.z = pk2(b_[0], b_[1]); o_.w = pk2(b_[2], b_[3]); *(u32x4*)(dp) = o_; }
                        sq += dot4(v0) + dot4(v1);
                    }
                    sq += shx(sq, 16, fq * 16 + fr); sq += shx(sq, 32, fq * 16 + fr);
                    if (fq == 0 && !dry) { if (u.pn < 2) ss_cq[row * 8 + u.pn * 4 + wc] = sq; else ss_ckv[row * 4 + wc] = sq; }
                } else if (wc == 0) {
#pragma unroll
                    for (int bj = 0; bj < 2; ++bj)
#pragma unroll
                        for (int n = 0; n < 2; ++n) { acc[ai][bj][m][n] *= rs; sq += dot4(acc[ai][bj][m][n]); }
                    sq += shx(sq, 16, fq * 16 + fr); sq += shx(sq, 32, fq * 16 + fr);
                    const float rg = rsq(sq * (1.0f / 64.0f) + EPS);
#pragma unroll
                    for (int n = 0; n < 2; ++n) {
                        const int d = fq * 8 + n * 4;
                        const f32x4 g1 = *(const f32x4*)(gpe + d), g2 = *(const f32x4*)(gpe + 32 + d);
                        const f32x4 c01 = *(const f32x4*)(cst + row * 32 + d), c23 = *(const f32x4*)(cst + row * 32 + d + 2);
                        const f32x4 y1 = acc[ai][0][m][n] * g1 * rg, y2 = acc[ai][1][m][n] * g2 * rg;
                        const f32x4 cs = {c01[0], c01[2], c23[0], c23[2]}, sn = {c01[1], c01[3], c23[1], c23[3]};
                        store_bf4(Kpe + row * 64 + d, y1 * cs - y2 * sn); store_bf4(Kpe + row * 64 + 32 + d, y1 * sn + y2 * cs);
                    }
                }
            }
    }
};
struct EpiUq {
    static constexpr bool PERM = true;
    const float* ss_cq; bf16_t* Qn; bf16_t* Qp; const float* gqn; const float* gqp; const f32x2* cst; LAS float* xch;
    DI void operator()(AccT& acc, const Unit& u, int wr, int wc, int fr, int fq, const bool dry) const {
        const float scq = 0.07216878364870322f * LOG2E;
        const int ln = fq * 16 + fr;
        if (u.pn < 8) {
#pragma unroll
            for (int ai = 0; ai < 2; ++ai)
#pragma unroll
                for (int m = 0; m < 4; ++m) {
                    const int rl = ai * 128 + wr * 64 + m * 16 + fr; const size_t row = (size_t)u.pm * 256 + rl;
                    const float rs = rsq(sum8(ss_cq + row * 8) * (1.0f / 512.0f) + EPS);
#pragma unroll
                    for (int bj = 0; bj < 2; ++bj) {
                        float sq = 0.f;
#pragma unroll
                        for (int n = 0; n < 2; ++n) { acc[ai][bj][m][n] *= rs; sq += dot4(acc[ai][bj][m][n]); }
                        sq += shx(sq, 16, ln); sq += shx(sq, 32, ln);
                        if (fq == 0) xch[(rl * 2 + bj) * 4 + wc] = sq;
                    }
                }
            asm volatile("s_waitcnt lgkmcnt(0)" ::: "memory"); __builtin_amdgcn_s_barrier(); asm volatile("" ::: "memory");
#pragma unroll
            for (int ai = 0; ai < 2; ++ai)
#pragma unroll
                for (int m = 0; m < 4; ++m) {
                    const int rl = ai * 128 + wr * 64 + m * 16 + fr; const size_t row = (size_t)u.pm * 256 + rl;
#pragma unroll
                    for (int bj = 0; bj < 2; ++bj) {
                        const f32x4 pt = *(const LAS f32x4*)(xch + (rl * 2 + bj) * 4);
                        const float rg = rsq(((pt[0] + pt[1]) + (pt[2] + pt[3])) * (1.0f / 128.0f) + EPS) * scq;
                        { const int c = wc * 32 + fq * 8; const f32x4 g0 = *(const f32x4*)(gqn + c), g1 = *(const f32x4*)(gqn + c + 4);
                            { const f32x4 a_ = acc[ai][bj][m][0] * g0 * rg, b_ = acc[ai][bj][m][1] * g1 * rg; u32x4 o_; o_.x = pk2(a_[0], a_[1]); o_.y = pk2(a_[2], a_[3]); o_.z = pk2(b_[0], b_[1]); o_.w = pk2(b_[2], b_[3]); *(u32x4*)(Qn + row * 2048 + (2 * u.pn + bj) * 128 + c) = o_; } }
                    }
                }
        } else {
            const int head = (u.pn - 8) * 4 + wc;
#pragma unroll
            for (int ai = 0; ai < 2; ++ai)
#pragma unroll
                for (int m = 0; m < 4; ++m) {
                    const size_t row = (size_t)u.pm * 256 + ai * 128 + wr * 64 + m * 16 + fr;
                    const float rs = rsq(sum8(ss_cq + row * 8) * (1.0f / 512.0f) + EPS); float sq = 0.f;
#pragma unroll
                    for (int bj = 0; bj < 2; ++bj)
#pragma unroll
                        for (int n = 0; n < 2; ++n) { acc[ai][bj][m][n] *= rs; sq += dot4(acc[ai][bj][m][n]); }
                    sq += shx(sq, 16, ln); sq += shx(sq, 32, ln);
                    const float rg = rsq(sq * (1.0f / 64.0f) + EPS) * scq;
#pragma unroll
                    for (int n = 0; n < 2; ++n) {
                        const int d = fq * 8 + n * 4;
                        const f32x4 g1 = *(const f32x4*)(gqp + d), g2 = *(const f32x4*)(gqp + 32 + d);
                        const f32x4 c01 = *(const f32x4*)(cst + row * 32 + d), c23 = *(const f32x4*)(cst + row * 32 + d + 2);
                        const f32x4 y1 = acc[ai][0][m][n] * g1 * rg, y2 = acc[ai][1][m][n] * g2 * rg;
                        const f32x4 cs = {c01[0], c01[2], c23[0], c23[2]}, sn = {c01[1], c01[3], c23[1], c23[3]};
                        store_bf4(Qp + row * 1024 + head * 64 + d, y1 * cs - y2 * sn); store_bf4(Qp + row * 1024 + head * 64 + 32 + d, y1 * sn + y2 * cs);
                    }
                }
        }
    }
};
struct EpiUkv {
    static constexpr bool PERM = true;
    const float* ss_ckv; bf16_t* Kn; bf16_t* Vt; const float* gk; LAS float* xch;
    DI void operator()(AccT& acc, const Unit& u, int wr, int wc, int fr, int fq, const bool dry) const {
        const int ln = fq * 16 + fr;
#pragma unroll
        for (int ai = 0; ai < 2; ++ai)
#pragma unroll
            for (int m = 0; m < 4; ++m) {
                const int rl = ai * 128 + wr * 64 + m * 16 + fr; const size_t row = (size_t)u.pm * 256 + rl;
                const float rs = rsq(sum4(ss_ckv + row * 4) * (1.0f / 256.0f) + EPS); float sq = 0.f;
#pragma unroll
                for (int n = 0; n < 2; ++n) { acc[ai][0][m][n] *= rs; sq += dot4(acc[ai][0][m][n]); acc[ai][1][m][n] *= rs; }
                sq += shx(sq, 16, ln); sq += shx(sq, 32, ln);
                if (fq == 0) xch[rl * 4 + wc] = sq;
            }
        asm volatile("s_waitcnt lgkmcnt(0)" ::: "memory"); __builtin_amdgcn_s_barrier(); asm volatile("" ::: "memory");
#pragma unroll
        for (int ai = 0; ai < 2; ++ai)
#pragma unroll
            for (int m = 0; m < 4; ++m) {
                const int rl = ai * 128 + wr * 64 + m * 16 + fr; const size_t row = (size_t)u.pm * 256 + rl;
                const f32x4 pt = *(const LAS f32x4*)(xch + rl * 4);
                const float rg = rsq(((pt[0] + pt[1]) + (pt[2] + pt[3])) * (1.0f / 128.0f) + EPS);
                { const int c = wc * 32 + fq * 8; const f32x4 g0 = *(const f32x4*)(gk + c), g1 = *(const f32x4*)(gk + c + 4);
                    { const f32x4 a_ = acc[ai][0][m][0] * g0 * rg, b_ = acc[ai][0][m][1] * g1 * rg; u32x4 o_; o_.x = pk2(a_[0], a_[1]); o_.y = pk2(a_[2], a_[3]); o_.z = pk2(b_[0], b_[1]); o_.w = pk2(b_[2], b_[3]); *(u32x4*)(Kn + row * 2048 + u.pn * 128 + c) = o_; } }
            }
        const size_t row0 = (size_t)u.pm * 256 + wr * 64 + fr;
        const int b = (int)(row0 >> 12), s0_ = (int)(row0 & 4095), s0 = (s0_ & ~15) | vperm16(s0_ & 15);
        bf16_t* vb = Vt + ((size_t)(b * 16 + u.pn) * 128 + wc * 32 + fq * 8) * S + s0;
#pragma unroll
        for (int ai = 0; ai < 2; ++ai)
#pragma unroll
            for (int m = 0; m < 4; ++m)
#pragma unroll
                for (int n = 0; n < 2; ++n) {
                    bf16_t* p = vb + (size_t)(n * 4) * S + ai * 128 + m * 16;
                    const f32x4 v = acc[ai][1][m][n];
                    const unsigned w0 = pk2(v[0], v[1]), w1 = pk2(v[2], v[3]);
                    p[0] = (bf16_t)(w0 & 0xffff); p[S] = (bf16_t)(w0 >> 16); p[2 * S] = (bf16_t)(w1 & 0xffff); p[3 * S] = (bf16_t)(w1 >> 16);
                    SCHED_B;
                }
    }
};
struct EpiFfnIn {
    static constexpr bool PERM = true;
    const float* ss; const float* cw; const float* cb; bf16_t* act; LAS float* xch;
    template <int CTRL> static DI float dppo(float old, float v) { return __builtin_bit_cast(float, __builtin_amdgcn_update_dpp(__builtin_bit_cast(int, old), __builtin_bit_cast(int, v), CTRL, 0xF, 0xF, false)); }
    DI void operator()(AccT& acc, const Unit& u, int wr, int wc, int fr, int fq, const bool dry) const {
        const int bidx = u.pm / 17, sbase = 254 * (u.pm % 17) - 2;
#pragma unroll
        for (int ai = 0; ai < 2; ++ai)
#pragma unroll
            for (int m = 0; m < 4; ++m) {
                int s = sbase + ai * 128 + wr * 64 + fr * 4 + m; s = s < 0 ? 0 : (s > S - 1 ? S - 1 : s);
                const float rs = rsq(sum16c(ss + (size_t)(bidx * S + s) * 16, fq, fq * 16 + fr) * (1.0f / D) + EPS);
#pragma unroll
                for (int bj = 0; bj < 2; ++bj)
#pragma unroll
                    for (int n = 0; n < 2; ++n) acc[ai][bj][m][n] *= rs;
            }
        if (fr == 15) {
#pragma unroll
            for (int ai = 0; ai < 2; ++ai)
#pragma unroll
                for (int bj = 0; bj < 2; ++bj)
#pragma unroll
                    for (int n = 0; n < 2; ++n) {
                        LAS float* xp = xch + (2 * ai + wr) * 512 + bj * 128 + wc * 32 + n * 16 + fq * 4;
                        *(LAS f32x4*)xp = acc[ai][bj][2][n]; *(LAS f32x4*)(xp + 256) = acc[ai][bj][3][n];
                    }
        }
        asm volatile("s_waitcnt lgkmcnt(0)" ::: "memory"); __builtin_amdgcn_s_barrier(); asm volatile("" ::: "memory");
#pragma unroll
        for (int n = 0; n < 2; ++n) {
            const int cl = wc * 32 + n * 16 + fq * 4  , ch = u.pn * 128 + wc * 32 + fq * 8 + n * 4  ;
            const f32x4 wa0 = *(const f32x4*)(cw + ch), wa1 = *(const f32x4*)(cw + 2 * DFF + ch), wa2 = *(const f32x4*)(cw + 4 * DFF + ch), ba = *(const f32x4*)(cb + ch);
            const f32x4 wg0 = *(const f32x4*)(cw + DFF + ch), wg1 = *(const f32x4*)(cw + 3 * DFF + ch), wg2 = *(const f32x4*)(cw + 5 * DFF + ch), bg = *(const f32x4*)(cb + DFF + ch);
#pragma unroll
            for (int ai = 0; ai < 2; ++ai) {
                const int blk = 2 * ai + wr;
                f32x4 X0a = {0.f, 0.f, 0.f, 0.f}, X1a = X0a, X0g = X0a, X1g = X0a;
                if (blk > 0) { const LAS float* xb = xch + (blk - 1) * 512; X0a = *(const LAS f32x4*)(xb + cl); X1a = *(const LAS f32x4*)(xb + 256 + cl); X0g = *(const LAS f32x4*)(xb + 128 + cl); X1g = *(const LAS f32x4*)(xb + 256 + 128 + cl); }
                f32x4 q2a, q3a, q2g, q3g;
#pragma unroll
                for (int e = 0; e < 4; ++e) { q2a[e] = dppo<0x111>(X0a[e], acc[ai][0][2][n][e]); q3a[e] = dppo<0x111>(X1a[e], acc[ai][0][3][n][e]);
                                              q2g[e] = dppo<0x111>(X0g[e], acc[ai][1][2][n][e]); q3g[e] = dppo<0x111>(X1g[e], acc[ai][1][3][n][e]); }
                const f32x4 zero4 = {0.f, 0.f, 0.f, 0.f};
                const bool first = (sbase < 0) && (blk == 0) && (fr == 0);
#pragma unroll
                for (int m = 0; m < 4; ++m) {
                    const f32x4 ua = acc[ai][0][m][n], ug = acc[ai][1][m][n];
                    f32x4 p1a = (m == 0) ? q3a : acc[ai][0][m > 0 ? m - 1 : 0][n], p1g = (m == 0) ? q3g : acc[ai][1][m > 0 ? m - 1 : 0][n];
                    f32x4 p2a = (m == 0) ? q2a : (m == 1) ? q3a : acc[ai][0][m > 1 ? m - 2 : 0][n], p2g = (m == 0) ? q2g : (m == 1) ? q3g : acc[ai][1][m > 1 ? m - 2 : 0][n];
                    if (m == 2 && first) { p1a = zero4; p1g = zero4; p2a = zero4; p2g = zero4; }
                    if (m == 3 && first) { p2a = zero4; p2g = zero4; }
                    const f32x4 ca = ba + wa0 * p2a + wa1 * p1a + wa2 * ua;
                    const f32x4 cg_ = bg + wg0 * p2g + wg1 * p1g + wg2 * ug;
                    f32x4 o;
#pragma unroll
                    for (int e = 0; e < 4; ++e) o[e] = ca[e] * cg_[e] * __builtin_amdgcn_rcpf(1.0f + __builtin_amdgcn_exp2f(-LOG2E * cg_[e]));
                    const int Rt = ai * 128 + wr * 64 + fr * 4 + m, s = sbase + Rt;
                    if (Rt >= 2 && s < S) store_bf4(act + ((size_t)bidx * S + s) * DFF + ch, o);
                }
                SCHED_B;
            }
        }
    }
};

struct AttnArgs {
    const bf16_t* Q; const bf16_t* Q2; const bf16_t* K; const bf16_t* K2; const bf16_t* Vt; bf16_t* O;
    const int* pos; const float* ss_q; const float* gn; const float* gp; const f32x2* cs;
    int dry; const int* pmax; const float* rel; const float* lq1; const float* lk1; const float* lq2; const float* lk2; const float* subg; float lam_init;
};
DI int crow(int i, int h) { return (i & 3) + 8 * (i >> 2) + 4 * h; }
template <int SI> DI bf16x8 pack8(const f32x16& x) {
    u32x4 p; p.x = pk2(x[8 * SI], x[8 * SI + 1]); p.y = pk2(x[8 * SI + 2], x[8 * SI + 3]); p.z = pk2(x[8 * SI + 4], x[8 * SI + 5]); p.w = pk2(x[8 * SI + 6], x[8 * SI + 7]);
    return __builtin_bit_cast(bf16x8, p);
}
#define MFMA32(a, b, c) __builtin_amdgcn_mfma_f32_32x32x16_bf16((a), (b), (c), 0, 0, 0)

template <bool DIFF>
DI void attn_unit(const AttnArgs& a, LAS unsigned char* lds, int b, int head, int qb, const int wid_in) {
    int wid = wid_in; asm volatile("" : "+s"(wid));
    constexpr int DQK = DIFF ? 64 : 192, NKS = DQK / 16, KST = DQK * 2 + 16, KBYTES = 64 * KST, VST = 144, NH = DIFF ? 8 : 16;
    constexpr int NKL = DIFF ? 1 : 3;
    const int lane = lane_asm(), tid = wid * 64 + lane, r = lane & 31, h = lane >> 5;
    const int qw = qb * 256 + wid * 32, nt = (qb + 1) * 4, jlast = qw >> 5;
    const int pvar = PROBE_BITS ? (a.dry >> 1) : 0;
    const size_t tokq = (size_t)b * S + qw + r;
    LAS float* lut = (LAS float*)(lds + LUT_OFF);
    const int qpos = a.pos[tokq];
    int qpmin = qpos; unsigned long long nearA = 0, nearB = 0;
    float lam = 0.f;
    if constexpr (DIFF) {
#pragma unroll
        for (int o = 1; o < 64; o <<= 1) { const int t2 = shxi(qpmin, o, lane); qpmin = t2 < qpmin ? t2 : qpmin; }
        qpmin = __builtin_amdgcn_readfirstlane(qpmin);
        nearA = __builtin_amdgcn_ballot_w64(qpmin - a.pmax[b * 128 + lane] < 255); nearB = __builtin_amdgcn_ballot_w64(qpmin - a.pmax[b * 128 + 64 + lane] < 255);
        const float s1 = wave_sum(a.lq1[lane] * a.lk1[lane], lane), s2 = wave_sum(a.lq2[lane] * a.lk2[lane], lane);
        lam = expf(s1) - expf(s2) + a.lam_init;
    }
    f32x16 O[4];

    for (int c = 0; c < (DIFF ? 2 : 1); ++c) {
        bf16x8 qf[NKS];
        if constexpr (DIFF) {
#pragma unroll
            for (int ks = 0; ks < NKS; ++ks) qf[ks] = *(const bf16x8*)(a.Q + tokq * 1024 + head * 128 + c * 64 + ks * 16 + h * 8);
        } else {
#pragma unroll
            for (int ks = 0; ks < 8; ++ks) qf[ks] = *(const bf16x8*)(a.Q + tokq * 2048 + head * 128 + ks * 16 + h * 8);
#pragma unroll
            for (int ks = 0; ks < 4; ++ks) qf[8 + ks] = *(const bf16x8*)(a.Q2 + tokq * 1024 + head * 64 + ks * 16 + h * 8);
        }
        float mrun = 0.f, lrun = 0.f;
#pragma unroll
        for (int v = 0; v < 4; ++v)
#pragma unroll
            for (int i = 0; i < 16; ++i) O[v][i] = 0.f;

        constexpr int VBYTES = 128 * VST;
        u32x4 kreg[NKL], vreg[2]; int kpreg = 0;
        LAS int* kposl = (LAS int*)(lds + KPOS_OFF);
        auto load_tile = [&](int t) {
            const int key0 = t * 64;
            if constexpr (DIFF) {
                const int row = tid >> 3, cc = tid & 7;
                kreg[0] = *(const u32x4*)(a.K + ((size_t)b * S + key0 + row) * 1024 + head * 128 + c * 64 + cc * 8);
                if (tid < 64) kpreg = a.pos[(size_t)b * S + key0 + tid];
            } else {
                { const int row = tid >> 3, c8 = (tid & 7) * 8; const size_t tk = (size_t)b * S + key0 + row;
                    const bf16_t* kp_ = a.K + tk * 2048 + head * 128 + c8;
                    kreg[0] = *(const u32x4*)kp_; kreg[1] = *(const u32x4*)(kp_ + 64); kreg[2] = *(const u32x4*)(a.K2 + tk * 64 + c8); }
            }
#pragma unroll
            for (int i = 0; i < 2; ++i) { const int id = tid + 512 * i, vrow = id >> 3, cc = id & 7;
                vreg[i] = *(const u32x4*)(a.Vt + ((size_t)(b * NH + head) * 128 + vrow) * S + key0 + cc * 8); }
        };
        auto store_tile = [&](int kb, int vb) {
            LAS unsigned char* kp = lds + kb * KBYTES;
            if constexpr (DIFF) {
                const int row = tid >> 3, cc = tid & 7; *(LAS u32x4*)(kp + row * KST + cc * 16) = kreg[0];
                if (tid < 64) kposl[vb * 64 + tid] = kpreg;
            } else {
                { LAS unsigned char* kq = kp + (tid >> 3) * KST + (tid & 7) * 16; *(LAS u32x4*)kq = kreg[0]; *(LAS u32x4*)(kq + 128) = kreg[1]; *(LAS u32x4*)(kq + 256) = kreg[2]; }
            }
#pragma unroll
            for (int i = 0; i < 2; ++i) { const int id = tid + 512 * i, vrow = id >> 3, cc = id & 7;
                *(LAS u32x4*)(lds + 2 * KBYTES + vb * VBYTES + vrow * VST + cc * 16) = vreg[i]; }
        };
        f32x16 Sc;
        auto step = [&](const LAS unsigned char* Kn, const LAS unsigned char* Vb, const LAS int* kpl, int j) {
            if constexpr (DIFF) {
                if (((j < 64 ? nearA >> j : nearB >> (j - 64)) & 1ull) != 0) {
                    const LAS int* kpp = kpl + 4 * h;
#pragma unroll
                    for (int i = 0; i < 16; ++i) { int d0 = qpos - kpp[(i & 3) + 8 * (i >> 2)]; d0 = d0 < 0 ? 0 : (d0 > 255 ? 255 : d0); Sc[i] += lut[d0]; }
                }
            }
            if (j == jlast) {
                int r_ = r - 4 * h; asm volatile("" : "+v"(r_));
#pragma unroll
                for (int i = 0; i < 16; ++i) if ((i & 3) + 8 * (i >> 2) > r_) Sc[i] = -1e30f;
            }
            f32x16 Nx;
#pragma unroll
            for (int i = 0; i < 16; ++i) Nx[i] = 0.f;
#pragma unroll
            for (int ks = 0; ks < NKS; ++ks) { const bf16x8 a0 = *(const LAS bf16x8*)(Kn + r * KST + ks * 32 + h * 16); Nx = MFMA32(a0, qf[ks], Nx); }
            bf16x8 vf0, vf1, vf2, vf3, vf4, vf5, vf6, vf7;
            if constexpr (false) {
                const unsigned va = (unsigned)(size_t)Vb + (unsigned)(r * VST + h * 16);
                asm volatile("ds_read_b128 %0, %8\n\tds_read_b128 %1, %8 offset:32\n\tds_read_b128 %2, %8 offset:4608\n\tds_read_b128 %3, %8 offset:4640\n\t"
                             "ds_read_b128 %4, %8 offset:9216\n\tds_read_b128 %5, %8 offset:9248\n\tds_read_b128 %6, %8 offset:13824\n\tds_read_b128 %7, %8 offset:13856"
                             : "=&v"(vf0), "=&v"(vf1), "=&v"(vf2), "=&v"(vf3), "=&v"(vf4), "=&v"(vf5), "=&v"(vf6), "=&v"(vf7) : "v"(va) : "memory");
            }
            float mxr = 0.f;
            if (!(pvar & 2)) {
            float mx = Sc[0];
#pragma unroll
            for (int i = 1; i < 16; ++i) mx = fmaxf(mx, Sc[i]);
            mx = fmaxf(mx, shx(mx, 32, lane));
            mxr = mx - mrun;
            float ps = 0.f;
#pragma unroll
            for (int i = 0; i < 16; ++i) { Sc[i] = __builtin_amdgcn_exp2f(Sc[i] - mrun); ps += Sc[i]; }
            lrun += ps;
            }
            const bf16x8 p0 = pack8<0>(Sc), p1 = pack8<1>(Sc);
            if constexpr (false) {
                asm volatile("s_waitcnt lgkmcnt(0)" : "+v"(vf0), "+v"(vf1), "+v"(vf2), "+v"(vf3), "+v"(vf4), "+v"(vf5), "+v"(vf6), "+v"(vf7) :: "memory");
                O[0] = MFMA32(vf0, p0, O[0]); O[1] = MFMA32(vf2, p0, O[1]); O[2] = MFMA32(vf4, p0, O[2]); O[3] = MFMA32(vf6, p0, O[3]);
                O[0] = MFMA32(vf1, p1, O[0]); O[1] = MFMA32(vf3, p1, O[1]); O[2] = MFMA32(vf5, p1, O[2]); O[3] = MFMA32(vf7, p1, O[3]);
            } else {
#pragma unroll
                for (int v = 0; v < 4; ++v) {
                    const LAS unsigned char* vp = Vb + (v * 32 + r) * VST + h * 16;
                    O[v] = MFMA32(*(const LAS bf16x8*)vp, p0, O[v]);
                    O[v] = MFMA32(*(const LAS bf16x8*)(vp + 32), p1, O[v]);
                }
            }
            if (j == 0 || __builtin_amdgcn_ballot_w64(mxr > 8.0f) != 0) {
                const float dlt = (j == 0) ? mxr : fmaxf(mxr, 0.f), alpha = __builtin_amdgcn_exp2f(-dlt);
                mrun += dlt; lrun *= alpha;
#pragma unroll
                for (int v = 0; v < 4; ++v)
#pragma unroll
                    for (int i = 0; i < 16; ++i) O[v][i] *= alpha;
            }
            Sc = Nx;
        };
        load_tile(0);
        __syncthreads();
        if constexpr (DIFF) {
            if (c == 0 && tid < 256) {
                const int n = tid; int bk;
                if (n < 16) bk = n; else { const float lr = logf((float)n / 16.0f) / 2.0794415416798357f; bk = 16 + (int)(lr * 16.0f); bk = bk > 31 ? 31 : bk; }
                lut[n] = (a.rel[bk * 8 + head] - a.rel[31 * 8 + head]) * LOG2E;
            }
        }
        store_tile(0, 0);
        __syncthreads();
        if (nt > 1) load_tile(1);
        int vcur = 0, vprev = 2, vnxt = 1;
        for (int t = 0; t <= nt; ++t) {
            if (!(pvar & 1)) { if (t + 1 < nt) store_tile((t + 1) & 1, vnxt);
            if (t + 2 < nt) load_tile(t + 2); }
            SCHED_B;
            const LAS unsigned char* Kt = lds + (t & 1) * KBYTES;
            if (t == 0) {
#pragma unroll
                for (int i = 0; i < 16; ++i) Sc[i] = 0.f;
#pragma unroll
                for (int ks = 0; ks < NKS; ++ks) { const bf16x8 a0 = *(const LAS bf16x8*)(Kt + r * KST + ks * 32 + h * 16); Sc = MFMA32(a0, qf[ks], Sc); }
            } else if (2 * t - 1 <= jlast) {
                step(Kt, lds + 2 * KBYTES + vprev * VBYTES + 64, kposl + vprev * 64 + 32, 2 * t - 1);
            }
            if (t < nt && 2 * t <= jlast) step(Kt + 32 * KST, lds + 2 * KBYTES + vcur * VBYTES, kposl + vcur * 64, 2 * t);
            SCHED_B;
            if (!(pvar & 4)) { asm volatile("s_waitcnt lgkmcnt(0)" ::: "memory"); __builtin_amdgcn_s_barrier(); asm volatile("" ::: "memory"); }
            vprev = vcur; vcur = vnxt; vnxt = (vnxt == 2) ? 0 : vnxt + 1;
        }
        lrun += shx(lrun, 32, lane);
        const float inv = 1.0f / lrun;
        if constexpr (DIFF) {
            const int lane = lane_asm(), h = lane >> 5;
            LAS unsigned* stash = (LAS unsigned*)(lds + 73728 + wid * 8192) + lane;
            if (c == 0) {
#pragma unroll
                for (int v = 0; v < 4; ++v)
#pragma unroll
                    for (int i = 0; i < 8; ++i) stash[(v * 8 + i) * 64] = pk2(O[v][2 * i] * inv, O[v][2 * i + 1] * inv);
            } else {
                float sq = 0.f;
#pragma unroll
                for (int v = 0; v < 4; ++v)
#pragma unroll
                    for (int i = 0; i < 8; ++i) { const unsigned w = stash[(v * 8 + i) * 64];
                        O[v][2 * i] = bf_lo(w) - lam * (O[v][2 * i] * inv); O[v][2 * i + 1] = bf_hi(w) - lam * (O[v][2 * i + 1] * inv);
                        sq += O[v][2 * i] * O[v][2 * i] + O[v][2 * i + 1] * O[v][2 * i + 1]; if ((i & 3) == 3) SCHED_B; }
                sq += shx(sq, 32, lane);
                const float rn = rsq(sq * (1.0f / 128.0f) + EPS) * (1.0f - a.lam_init);
#pragma unroll
                for (int v = 0; v < 4; ++v)
#pragma unroll
                    for (int g = 0; g < 4; ++g) { const f32x4 sg = *(const f32x4*)(a.subg + v * 32 + 8 * g + 4 * h);
#pragma unroll
                        for (int j = 0; j < 4; ++j) O[v][4 * g + j] *= rn * sg[j]; SCHED_B; }
            }
        } else {
#pragma unroll
            for (int v = 0; v < 4; ++v)
#pragma unroll
                for (int i = 0; i < 16; ++i) O[v][i] *= inv;
        }
    }
    {
        const int lane = lane_asm(), r = lane & 31, h = lane >> 5;
        LAS unsigned char* st = lds + wid * (32 * 272);
#pragma unroll
        for (int v = 0; v < 4; ++v)
#pragma unroll
            for (int g = 0; g < 4; ++g) { u32x2 w; w.x = pk2(O[v][4 * g], O[v][4 * g + 1]); w.y = pk2(O[v][4 * g + 2], O[v][4 * g + 3]); *(LAS u32x2*)(st + r * 272 + (v * 32 + 8 * g + 4 * h) * 2) = w; }
        asm volatile("s_waitcnt lgkmcnt(0)" ::: "memory");
        constexpr int OP = DIFF ? 1024 : 2048;
        if (!a.dry)
#pragma unroll
        for (int k = 0; k < 8; ++k) { const int id = lane + 64 * k, row = id >> 4, cc = id & 15;
            const u32x4 w = *(const LAS u32x4*)(st + row * 272 + cc * 16);
            *(u32x4*)(a.O + ((size_t)b * S + qw + row) * OP + head * 128 + cc * 8) = w; }
    }
}

template <bool DIFF>
DI void attn_phase(const AttnArgs& a, LAS unsigned char* lds, const int wid) {
    constexpr int BH = DIFF ? 32 : 64, NU = BH * 16, NHD = DIFF ? 8 : 16;
    const int G = gridDim.x, c = blockIdx.x;
    for (int k = 0;; ++k) {
        const long base = (long)k * G; if (base >= NU) break;
        const long ul = (k & 1) ? base + (G - 1 - c) : base + c;
        if (ul >= NU) continue;
        const int u = (int)ul, qb = 15 - u / BH, bh = u % BH;
        attn_unit<DIFF>(a, lds, bh / NHD, bh % NHD, qb, wid);
    }
    __syncthreads();
}

DI int wmap(int mode, int n0) {
    if (mode == 1) { const int tile = n0 >> 8, p = n0 & 255; return tile * 256 + ((p >> 5) & 3) * 64 + (p >> 7) * 32; }
    if (mode == 2) { const int tile = n0 >> 8, p = n0 & 255; return (p >> 7) * DFF + tile * 128 + (p & 127); }
    if (mode == 3) { if (n0 < 2048) return 192 * (n0 >> 7) + (n0 & 127); const int q = n0 - 2048, tile = q >> 8, p = q & 255; return 192 * (tile * 4 + ((p >> 5) & 3)) + 128 + 32 * (p >> 7); }
    return n0;
}
DI void convert_w(const float* W, int K, int Nsrc, const float* gain, bf16_t* dst, int ndst, int mode, LAS float* scr, int gw, int NGW, int& rot) {
    const int lane = lane_asm();
    if (ndst % 64 == 0) {
        const int nblk = ndst / 64, items = (K / 32) * nblk;
        int first = gw - rot; if (first < 0) first += NGW;
        rot = (rot + items) % NGW;
        for (int it = first; it < items; it += NGW) {
            const int kb = it / nblk, nb = it % nblk, k0 = 32 * kb, n0 = 64 * nb, sc = wmap(mode, n0 + (lane & 32)) + (lane & 31);
            float wv[32];
#pragma unroll
            for (int i = 0; i < 32; ++i) wv[i] = W[(size_t)(k0 + i) * Nsrc + sc];
            if (gain) {
#pragma unroll
                for (int i = 0; i < 32; ++i) wv[i] *= gain[k0 + i];
            }
#pragma unroll
            for (int i = 0; i < 32; ++i) scr[i * 65 + lane] = wv[i];
            asm volatile("s_waitcnt lgkmcnt(0)" ::: "memory");
            const int c4 = lane & 3;
#pragma unroll
            for (int j = 0; j < 4; ++j) { const int n = (lane >> 2) + 16 * j; const LAS float* sp = scr + (8 * c4) * 65 + n;
                u32x4 o; o.x = pk2(sp[0 * 65], sp[1 * 65]); o.y = pk2(sp[2 * 65], sp[3 * 65]); o.z = pk2(sp[4 * 65], sp[5 * 65]); o.w = pk2(sp[6 * 65], sp[7 * 65]);
                *(u32x4*)(dst + (size_t)(n0 + n) * K + k0 + 8 * c4) = o; }
            asm volatile("s_waitcnt lgkmcnt(0)" ::: "memory");
        }
        return;
    }
    const int nblk = ndst / 32, items = (K / 64) * nblk;
    int first = gw - rot; if (first < 0) first += NGW;
    rot = (rot + items) % NGW;
    for (int it = first; it < items; it += NGW) {
        const int kb = it / nblk, nb = it % nblk, k0 = 64 * kb, n0 = 32 * nb, sc0 = wmap(mode, n0);
        float wv[32];
#pragma unroll
        for (int i = 0; i < 32; ++i) { const int kk = 2 * i + (lane >> 5); wv[i] = W[(size_t)(k0 + kk) * Nsrc + sc0 + (lane & 31)]; }
        if (gain) {
#pragma unroll
            for (int i = 0; i < 32; ++i) wv[i] *= gain[k0 + 2 * i + (lane >> 5)];
        }
#pragma unroll
        for (int i = 0; i < 32; ++i) { const int kk = 2 * i + (lane >> 5); scr[kk * 33 + (lane & 31)] = wv[i]; }
        asm volatile("s_waitcnt lgkmcnt(0)" ::: "memory");
        const int c8 = lane & 7;
#pragma unroll
        for (int j = 0; j < 4; ++j) { const int n = (lane >> 3) + 8 * j; const LAS float* s = scr + (8 * c8) * 33 + n;
            u32x4 o; o.x = pk2(s[0 * 33], s[1 * 33]); o.y = pk2(s[2 * 33], s[3 * 33]); o.z = pk2(s[4 * 33], s[5 * 33]); o.w = pk2(s[6 * 33], s[7 * 33]);
            *(u32x4*)(dst + (size_t)(n0 + n) * K + k0 + 8 * c8) = o; }
        asm volatile("s_waitcnt lgkmcnt(0)" ::: "memory");
    }
}

DI void norm128_inplace(bf16_t* buf, const float* ss, int ss_stride, const float* gain, float scale, int gw, int NGW, bool dry = false) {
    const int ln = lane_asm();
    const long total = (long)T * 16 * 16;
    for (long base = (long)gw * 512; base < total; base += (long)NGW * 512) {
        u32x4 w[8]; float rs[8];
#pragma unroll
        for (int k = 0; k < 8; ++k) { const long id = base + k * 64 + ln; w[k] = *(const u32x4*)(buf + id * 8); rs[k] = sum4(ss + (id >> 4) * ss_stride); }
#pragma unroll
        for (int k = 0; k < 8; ++k) {
            const long id = base + k * 64 + ln; const int c8 = (int)(id & 15) * 8;
            const float r = rsq(rs[k] * (1.0f / 128.0f) + EPS) * scale;
            const f32x4 g0 = *(const f32x4*)(gain + c8), g1 = *(const f32x4*)(gain + c8 + 4);
            u32x4 o; o.x = pk2(bf_lo(w[k].x) * g0[0] * r, bf_hi(w[k].x) * g0[1] * r); o.y = pk2(bf_lo(w[k].y) * g0[2] * r, bf_hi(w[k].y) * g0[3] * r);
            o.z = pk2(bf_lo(w[k].z) * g1[0] * r, bf_hi(w[k].z) * g1[1] * r); o.w = pk2(bf_lo(w[k].w) * g1[2] * r, bf_hi(w[k].w) * g1[3] * r);
            *(u32x4*)(buf + id * 8) = dry ? w[k] : o;
        }
    }
}
DI void qpe_inplace(bf16_t* Qp, const float* ss_q, const float* gain, const f32x2* cstab, float scale, long g0, long NGT, bool dry = false) {
    for (long th = g0; th < (long)T * 16; th += NGT) {
        const long tk = th >> 4;
        u32x4 w[8];
#pragma unroll
        for (int k = 0; k < 8; ++k) w[k] = *(const u32x4*)(Qp + th * 64 + k * 8);
        const float r = rsq((ss_q[th * 8 + 4] + ss_q[th * 8 + 5]) * (1.0f / 64.0f) + EPS) * scale;
#pragma unroll
        for (int k = 0; k < 4; ++k) {
            float x1[8], x2[8], y1[8], y2[8];
            x1[0] = bf_lo(w[k].x); x1[1] = bf_hi(w[k].x); x1[2] = bf_lo(w[k].y); x1[3] = bf_hi(w[k].y); x1[4] = bf_lo(w[k].z); x1[5] = bf_hi(w[k].z); x1[6] = bf_lo(w[k].w); x1[7] = bf_hi(w[k].w);
            x2[0] = bf_lo(w[k + 4].x); x2[1] = bf_hi(w[k + 4].x); x2[2] = bf_lo(w[k + 4].y); x2[3] = bf_hi(w[k + 4].y); x2[4] = bf_lo(w[k + 4].z); x2[5] = bf_hi(w[k + 4].z); x2[6] = bf_lo(w[k + 4].w); x2[7] = bf_hi(w[k + 4].w);
#pragma unroll
            for (int j = 0; j < 8; j += 2) {
                const f32x4 cs2 = *(const f32x4*)(cstab + tk * 32 + k * 8 + j);
                const f32x2 ga = *(const f32x2*)(gain + k * 8 + j), gb = *(const f32x2*)(gain + 32 + k * 8 + j);
                const float u1a = x1[j] * ga.x * r, u2a = x2[j] * gb.x * r, u1b = x1[j + 1] * ga.y * r, u2b = x2[j + 1] * gb.y * r;
                y1[j] = u1a * cs2[0] - u2a * cs2[1]; y2[j] = u1a * cs2[1] + u2a * cs2[0];
                y1[j + 1] = u1b * cs2[2] - u2b * cs2[3]; y2[j + 1] = u1b * cs2[3] + u2b * cs2[2];
            }
            u32x4 o1, o2;
            o1.x = pk2(y1[0], y1[1]); o1.y = pk2(y1[2], y1[3]); o1.z = pk2(y1[4], y1[5]); o1.w = pk2(y1[6], y1[7]);
            o2.x = pk2(y2[0], y2[1]); o2.y = pk2(y2[2], y2[3]); o2.z = pk2(y2[4], y2[5]); o2.w = pk2(y2[6], y2[7]);
            *(u32x4*)(Qp + th * 64 + k * 8) = dry ? w[k] : o1; *(u32x4*)(Qp + th * 64 + 32 + k * 8) = dry ? w[k + 4] : o2;
        }
    }
}

#define XB_TMO      128
#define XB_XCNT(j)  (256  + 64 * (j))
#define XB_XSUB(j)  (1280 + 64 * (j))
#define XB_XGEN(j)  (2304 + 64 * (j))
#define XB_TOP      3328
#define XB_TOPGEN   3392
#define XCD_BAR_WORDS 3456
#define XB_SPIN_CAP (1u << 18)

__device__ __forceinline__ unsigned xb_ld(unsigned* p)              { return __hip_atomic_load(p, __ATOMIC_RELAXED, __HIP_MEMORY_SCOPE_AGENT); }
__device__ __forceinline__ unsigned xb_add(unsigned* p, unsigned v) { return __hip_atomic_fetch_add(p, v, __ATOMIC_RELAXED, __HIP_MEMORY_SCOPE_AGENT); }
__device__ __forceinline__ unsigned xb_xcc_id() { return (unsigned)__builtin_amdgcn_s_getreg((3 << 11) | 20) & 0xFu; }
#define XB_SPIN(cond, bar) do { unsigned _sp = 0; while (cond) { __builtin_amdgcn_s_sleep(1); \
    if ((++_sp & 255u) == 0u) { if (xb_ld(&(bar)[XB_TMO])) break; if (_sp > XB_SPIN_CAP) { atomicAdd(&(bar)[XB_TMO], 1u); break; } } } } while (0)

struct XcdBarrier {
    unsigned* bar; unsigned x;
    volatile LAS unsigned* st;
};

__device__ __forceinline__ XcdBarrier xcd_barrier_post(unsigned* bar, volatile LAS unsigned* st, const int xb_wid) {
    XcdBarrier b; b.bar = bar; b.x = xb_xcc_id(); b.st = st;
    if ((xb_wid == 0 && lane_asm() == 0)) (void)xb_add(&bar[XB_XCNT(b.x)], 1u);
    return b;
}
__device__ __forceinline__ void xcd_barrier_complete(unsigned* bar, unsigned x, unsigned& nloc, unsigned& nx) {
    const unsigned G = gridDim.x * gridDim.y * gridDim.z;
    unsigned sum, cnt, mine, sp = 0u;
    for (;;) {
        sum = 0u; cnt = 0u; mine = 0u;
#pragma unroll
        for (unsigned j = 0; j < 16; ++j) { const unsigned c = xb_ld(&bar[XB_XCNT(j)]); sum += c; cnt += (c > 0u) ? 1u : 0u; mine = (j == x) ? c : mine; }
        if (sum == G) break;
        __builtin_amdgcn_s_sleep(1);
        if ((++sp & 255u) == 0u) { if (xb_ld(&bar[XB_TMO])) break; if (sp > XB_SPIN_CAP) { atomicAdd(&bar[XB_TMO], 1u); break; } }
    }
    nloc = mine > 0u ? mine : 1u; nx = cnt > 0u ? cnt : 1u;
}

__device__ __forceinline__ void xcd_barrier(const XcdBarrier& b, const int xb_wid) {
    asm volatile("s_waitcnt vmcnt(0)" ::: "memory");
    __syncthreads();
    if ((xb_wid == 0 && lane_asm() == 0)) {
        unsigned* bar = b.bar;
        __builtin_amdgcn_s_waitcnt(0);
        unsigned nloc = b.st[0], nx = b.st[1];
        if (nloc == 0u) { xcd_barrier_complete(bar, b.x, nloc, nx); b.st[0] = nloc; b.st[1] = nx; }
        const unsigned old = xb_add(&bar[XB_XSUB(b.x)], 1u);
        const unsigned gen = old / nloc;
        if (old + 1u == (gen + 1u) * nloc) {
            __builtin_amdgcn_fence(__ATOMIC_RELEASE, "agent");
            asm volatile("s_waitcnt vmcnt(0)" ::: "memory");
            const unsigned og = xb_add(&bar[XB_TOP], 1u);
            const unsigned tg = og / nx;
            if (og + 1u == (tg + 1u) * nx) xb_add(&bar[XB_TOPGEN], 1u);
            else XB_SPIN(xb_ld(&bar[XB_TOPGEN]) == tg, bar);
            __builtin_amdgcn_fence(__ATOMIC_ACQUIRE, "agent");
            xb_add(&bar[XB_XGEN(b.x)], 1u);
            asm volatile("s_waitcnt vmcnt(0)" ::: "memory");
        } else {
            XB_SPIN(xb_ld(&bar[XB_XGEN(b.x)]) == gen, bar);
            __builtin_amdgcn_fence(__ATOMIC_ACQUIRE, "agent");
            asm volatile("s_waitcnt vmcnt(0)" ::: "memory");
        }
    }
    __syncthreads();
}

struct Args { const void* in[34]; float* out; unsigned char* ws; long probe; };

__global__ void __launch_bounds__(512, 2) fwd_kernel(Args args) {
    extern __shared__ __attribute__((aligned(16))) unsigned char lds_raw[];
    LAS unsigned char* lds = (LAS unsigned char*)lds_raw;
    cg::grid_group grid = cg::this_grid();
    const int wid = __builtin_amdgcn_readfirstlane(threadIdx.x >> 6);
    const int G = gridDim.x, gw = blockIdx.x * 8 + wid, NGW = G * 8;
    const long NGT = (long)G * 512;
#define ltid() (wid * 64 + lane_asm())
#define gtid ((long)blockIdx.x * 512 + ltid())
#define NREP(bit) (1 + ((PROBE_BITS >> (bit)) & 1))
#define PDRY(c) ((c) && KARGS()->probe != 0)
    unsigned char* ws = args.ws;
    float* ssb = (float*)(ws + WS_SS);
    bf16_t* PB = (bf16_t*)(ws + WS_PB);
    bf16_t* WATT = (bf16_t*)(ws + WS_WATT);
    bf16_t* WFFN = (bf16_t*)(ws + WS_WFFN);
    bf16_t* X = (bf16_t*)(ws + WS_X);
    bf16_t* Y = (bf16_t*)(ws + WS_Y);
    bf16_t* R3 = (bf16_t*)(ws + WS_R3);
    bf16_t* R4 = (bf16_t*)(ws + WS_R4);
    LAS float* scr = (LAS float*)(lds + wid * 16384);
    f32x2* cstab = (f32x2*)(ws + WS_CS);
    int* pmaxb = (int*)(ws + WS_SS + 4 * MiB);
#define XIN INF(0)
#define PIN INF(1)
#define POSIN ((const int*)INF(2))
    typedef const Args __attribute__((address_space(4)))* KArgsP;
#define KARGS() ({ KArgsP kp_ = (KArgsP)__builtin_amdgcn_kernarg_segment_ptr(); asm volatile("" : "+s"(kp_)); kp_; })
#define INF(i) ((const float*)KARGS()->in[i])
    float* hout = args.out;
    { volatile LAS unsigned* st0 = (volatile LAS unsigned*)(lds + BARST_OFF); { const int l0 = lane_asm(); if (wid == 0 && l0 < 2) st0[l0] = 0u; } __syncthreads(); }
    const XcdBarrier xbar = xcd_barrier_post((unsigned*)(ws + WS_CTL), (volatile LAS unsigned*)(lds + BARST_OFF), wid);
#define GSYNC() do { xcd_barrier(xbar, wid); if (PROBE_BITS & 4) xcd_barrier(xbar, wid); } while (0)
    bf16_t* Wqkv_t = WATT; bf16_t* WoA_t = WATT + 3 * MiB;
    bf16_t* Wdq_t = WATT; bf16_t* Wuq_t = WATT + 1 * MiB; bf16_t* WoB_t = WATT + (5 * MiB) / 2; bf16_t* Wukv_t = WATT + (9 * MiB) / 2;
    bf16_t* Win_t = WFFN; bf16_t* Wout_t = WFFN + (11 * MiB) / 2; bf16_t* Wg_t = WFFN + (33 * MiB) / 4; bf16_t* Wp_t = WFFN + (37 * MiB) / 4;

    auto conv_attn = [&](int layer) {
        int rot = 0;
        if (layer < 2) {
            convert_w(INF(5) + (size_t)layer * 1024 * 3072, 1024, 3072, INF(4) + layer * 1024, Wqkv_t, 3072, 1, scr, gw, NGW, rot);
            convert_w(INF(13) + (size_t)layer * 1024 * 1024, 1024, 1024, nullptr, WoA_t, 1024, 0, scr, gw, NGW, rot);
        } else {
            const int j = layer - 2;
            convert_w(INF(20) + (size_t)j * 1024 * 512, 1024, 512, INF(4) + layer * 1024, Wdq_t, 512, 0, scr, gw, NGW, rot);
            if (j == 0) {
                convert_w(INF(15), 1024, 320, INF(14), Wdq_t + 512 * 1024, 256, 0, scr, gw, NGW, rot);
                convert_w(INF(15) + 256, 1024, 320, INF(14), Wdq_t + 768 * 1024, 32, 0, scr, gw, NGW, rot);
                convert_w(INF(15) + 288, 1024, 320, INF(14), Wdq_t + 896 * 1024, 32, 0, scr, gw, NGW, rot);
                convert_w(INF(17), 256, 4096, INF(16), Wukv_t, 4096, 0, scr, gw, NGW, rot);
            }
            convert_w(INF(22) + (size_t)j * 512 * 3072, 512, 3072, INF(21) + j * 512, Wuq_t, 3072, 3, scr, gw, NGW, rot);
            convert_w(INF(25) + (size_t)j * 2048 * 1024, 2048, 1024, nullptr, WoB_t, 1024, 0, scr, gw, NGW, rot);
        }
    };
    auto conv_ffn = [&](int layer) {
        int rot = 0;
        convert_w(INF(27) + (size_t)layer * 1024 * 5632, 1024, 5632, INF(26) + layer * 1024, Win_t, 5632, 2, scr, gw, NGW, rot);
        convert_w(INF(30) + (size_t)layer * DFF * 1024, DFF, 1024, nullptr, Wout_t, 1024, 0, scr, gw, NGW, rot);
        convert_w(INF(33) + (size_t)layer * 1024 * 1024, 1024, 1024, INF(31) + layer * 1024, Wg_t, 1024, 0, scr, gw, NGW, rot);
        convert_w(INF(32) + (size_t)layer * 256 * 1024, 256, 1024, nullptr, Wp_t, 1024, 0, scr, gw, NGW, rot);
        const float* pi = PIN + (size_t)layer * T * 256;
        {
            const long i0 = (long)blockIdx.x * 512 + ltid();
            for (long ib = i0; ib < (long)T * 256 / 8; ib += 4 * NGT) {
                f32x4 va[4], vb[4];
#pragma unroll
                for (int k = 0; k < 4; ++k) { const long i = ib + k * NGT; if (i < (long)T * 256 / 8) { va[k] = *(const f32x4*)(pi + i * 8); vb[k] = *(const f32x4*)(pi + i * 8 + 4); } }
#pragma unroll
                for (int k = 0; k < 4; ++k) { const long i = ib + k * NGT; if (i < (long)T * 256 / 8) {
                    u32x4 o; o.x = pk2(va[k][0], va[k][1]); o.y = pk2(va[k][2], va[k][3]); o.z = pk2(vb[k][0], vb[k][1]); o.w = pk2(vb[k][2], vb[k][3]);
                    *(u32x4*)(PB + i * 8) = o; } }
            }
        }
    };

    conv_attn(0);
    for (long i = gtid; i < 512; i += NGT) {
        typedef int i32x4 __attribute__((ext_vector_type(4)));
        const i32x4* pp_ = (const i32x4*)(POSIN + i * 32); i32x4 q_[8]; int mxp;
#pragma unroll
        for (int k = 0; k < 8; ++k) q_[k] = pp_[k];
        mxp = q_[0][0];
#pragma unroll
        for (int k = 0; k < 8; ++k)
#pragma unroll
            for (int e = 0; e < 4; ++e) mxp = q_[k][e] > mxp ? q_[k][e] : mxp;
        pmaxb[i] = mxp;
    }
    for (long i = gtid; i < (long)T * 32; i += NGT) {
        const int d = (int)(i & 31);
        const float ang = (float)POSIN[i >> 5] * expf(-9.210340371976184f * (float)d * (2.0f / 64.0f));
        float sn, cs; sincosf(ang, &sn, &cs);
        cstab[i] = (f32x2){cs, sn};
    }
    for (int m = gw; m < T; m += NGW) {
        const int ln = lane_asm();
        const f32x4* xr = (const f32x4*)(XIN + (size_t)m * D) + ln; float sq = 0.f; f32x4 v[4];
#pragma unroll
        for (int j = 0; j < 4; ++j) { v[j] = xr[64 * j]; sq += dot4(v[j]); }
        sq = wave_sum(sq, ln); if (ln < 16) ssb[(size_t)m * 16 + ln] = (ln == 0) ? sq : 0.f;
#pragma unroll
        for (int j = 0; j < 4; ++j) store_bf4(X + (size_t)m * D + 4 * ln + 256 * j, v[j]);
    }
    grid.sync();

    for (int layer = 0; layer < 4; ++layer) {
        bf16_t* IN = (layer & 1) ? Y : X; bf16_t* OT = (layer & 1) ? X : Y;
        float* ss_in = ssb + (size_t)SS_IN * T;
        float* ss_h1 = ssb + (size_t)SS_H1 * T;
        float* ss_h2 = ssb + (size_t)SS_H2 * T;
        bf16_t* Obuf; const bf16_t* WoT; int Ko;
        if (layer < 2) {
            bf16_t* QA = R3; bf16_t* KA = R3 + 16 * MiB; bf16_t* VtA = R3 + 32 * MiB;
            {
                pg8::Gemm g{IN, Wqkv_t, 1024, 0}; pg8::StaticOrder So; So.init(64, 12, G, blockIdx.x);
                EpiQkvA E{ss_in, INF(6) + layer * 64, INF(7) + layer * 64, QA, KA, VtA};

#ifndef NO_QKVA
                pg8::gemm_phase<EpiQkvA, false>(lds, g, So, E, wid, NREP(4), PROBE_BITS ? KARGS()->probe : 0);
#endif

            }
            GSYNC();
            {
                for (int rep = 0; rep < NREP(11); ++rep) conv_ffn(layer);
                AttnArgs a{}; a.Q = QA; a.K = KA; a.Vt = VtA; a.O = QA; a.pos = POSIN; a.rel = INF(3); a.pmax = pmaxb;
                a.lq1 = INF(8) + layer * 64; a.lk1 = INF(9) + layer * 64; a.lq2 = INF(10) + layer * 64; a.lk2 = INF(11) + layer * 64; a.subg = INF(12) + layer * 128;
                a.lam_init = (layer == 0) ? 0.2f : 0.35550906759096926f;

#ifndef NO_ATTN_DIFF
                { const int nrep = NREP(0); for (int rep = 0; rep < nrep; ++rep) { a.dry = PDRY(rep < nrep - 1) ? (1 | (int)((KARGS()->probe >> 14) & 7) << 1) : 0; attn_phase<true>(a, lds, wid); } }
#endif

            }
            GSYNC();
            Obuf = QA; WoT = WoA_t; Ko = 1024;
        } else {
            const int j = layer - 2;
            bf16_t* Kn = R3; bf16_t* VtB = R3 + 32 * MiB; bf16_t* Kpe = R3 + 64 * MiB;
            bf16_t* Qn = R4; bf16_t* Qp = R4 + 32 * MiB;
            bf16_t* cq = OT; bf16_t* ckv = OT + 8 * MiB;
            float* ss_cq = ssb + (size_t)SS_CQ * T; float* ss_ckv = ssb + (size_t)SS_CKV * T;
            {
                pg8::Gemm g{IN, Wdq_t, 1024, 0}; pg8::StaticOrder So; So.init(64, j == 0 ? 4 : 2, G, blockIdx.x);
                EpiDq E{ss_in, cq, ckv, Kpe, INF(19), cstab, ss_cq, ss_ckv};

#ifndef NO_DQ
                pg8::gemm_phase<EpiDq, false>(lds, g, So, E, wid, NREP(9), PROBE_BITS ? KARGS()->probe : 0);
#endif

            }
            GSYNC();
            {
                { pg8::Gemm g{cq, Wuq_t, 512, 0}; pg8::StaticOrder So; So.init(64, 12, G, blockIdx.x); EpiUq E{ss_cq, Qn, Qp, INF(23) + j * 128, INF(24) + j * 64, cstab, (LAS float*)(lds + XCH_OFF)};
#ifndef NO_UQ
 pg8::gemm_phase<EpiUq, true>(lds, g, So, E, wid, NREP(10), PROBE_BITS ? KARGS()->probe : 0);
#endif
 }
                if (j == 0) { pg8::Gemm g{ckv, Wukv_t, 256, 0}; pg8::StaticOrder So; So.init(64, 16, G, blockIdx.x); EpiUkv E{ss_ckv, Kn, VtB, INF(18), (LAS float*)(lds + XCH_OFF)};
#ifndef NO_UKV
 pg8::gemm_phase<EpiUkv, true>(lds, g, So, E, wid, NREP(10), PROBE_BITS ? KARGS()->probe : 0);
#endif
 }
            }
            GSYNC();
            {
                for (int rep = 0; rep < NREP(11); ++rep) conv_ffn(layer);
                AttnArgs a{}; a.Q = Qn; a.Q2 = Qp; a.K = Kn; a.K2 = Kpe; a.Vt = VtB; a.O = Qn; a.pos = POSIN;
                a.gn = INF(23) + j * 128; a.gp = INF(24) + j * 64; a.cs = cstab;

#ifndef NO_ATTN_MLA
                { const int nrep = NREP(1); for (int rep = 0; rep < nrep; ++rep) { a.dry = PDRY(rep < nrep - 1); attn_phase<false>(a, lds, wid); } }
#endif

            }
            GSYNC();
            Obuf = Qn; WoT = WoB_t; Ko = 2048;
        }
        {
            pg8::Gemm g{Obuf, WoT, Ko, 0}; pg8::StaticOrder So; So.init(64, 4, G, blockIdx.x);
            EpiRes E{IN, ss_h1};

#ifndef NO_RES
            pg8::gemm_phase<EpiRes, false>(lds, g, So, E, wid, NREP(5), PROBE_BITS ? KARGS()->probe : 0);
#endif
        }
        GSYNC();
        {
            if (layer < 3) { for (int rep = 0; rep < NREP(11); ++rep) conv_attn(layer + 1); __syncthreads(); }
            pg8::Gemm g{IN, Win_t, 1024, 1}; pg8::StaticOrder So; So.init(68, 22, G, blockIdx.x);
            EpiFfnIn E{ss_h1, INF(28) + (size_t)layer * 3 * 5632, INF(29) + (size_t)layer * 5632, R4, (LAS float*)(lds + XCH_OFF)};

#ifndef NO_FFNIN
            pg8::gemm_phase<EpiFfnIn, true>(lds, g, So, E, wid, NREP(6), PROBE_BITS ? KARGS()->probe : 0);
#endif

        }
        GSYNC();
        {
            { pg8::Gemm g{R4, Wout_t, DFF, 0}; pg8::StaticOrder So; So.init(64, 4, G, blockIdx.x); EpiRes E{IN, ss_h2};
#ifndef NO_RES
 pg8::gemm_phase<EpiRes, false>(lds, g, So, E, wid, NREP(7), PROBE_BITS ? KARGS()->probe : 0);
#endif
 }
            { pg8::Gemm g{PB, Wp_t, 256, 0}; pg8::StaticOrder So; So.init(64, 4, G, blockIdx.x); EpiPlain E{OT};
#ifndef NO_PLAIN
 pg8::gemm_phase<EpiPlain, false>(lds, g, So, E, wid, NREP(7), PROBE_BITS ? KARGS()->probe : 0);
#endif
 }
        }
        GSYNC();
        {
            pg8::Gemm g{IN, Wg_t, 1024, 0}; pg8::StaticOrder So; So.init(64, 4, G, blockIdx.x);
            EpiPle E{IN, OT, layer == 3 ? hout : nullptr, ss_h2, layer < 3 ? ss_in : nullptr};

#ifndef NO_PLE
            pg8::gemm_phase<EpiPle, false>(lds, g, So, E, wid, NREP(8), PROBE_BITS ? KARGS()->probe : 0);
#endif

        }
        if (layer < 3) GSYNC();
    }
}

extern "C" void kernel_launch(void* const* d_in, const int* in_sizes, int n_in, void* d_out, int out_size, void* d_ws, size_t ws_size, hipStream_t stream) {
    static int grid = 0;
    if (grid == 0) {
        if (n_in != 34 || out_size != T * D || ws_size < WS_END) { fprintf(stderr, "kernel_launch: unexpected shapes (n_in %d out %d ws %zu)\n", n_in, out_size, ws_size); grid = -1; return; }
        int dev = 0, cus = 0, per_cu = 0;
        hipGetDevice(&dev); hipDeviceGetAttribute(&cus, hipDeviceAttributeMultiprocessorCount, dev);
        if (hipFuncSetAttribute((const void*)fwd_kernel, hipFuncAttributeMaxDynamicSharedMemorySize, LDS_BYTES) != hipSuccess) { fprintf(stderr, "hipFuncSetAttribute failed\n"); grid = -1; return; }
        hipOccupancyMaxActiveBlocksPerMultiprocessor(&per_cu, (const void*)fwd_kernel, 512, LDS_BYTES);
        if (per_cu < 1) { fprintf(stderr, "occupancy query: %d\n", per_cu); per_cu = 1; }
        grid = cus * 1;
    }
    if (grid < 0) return;
    if (hipMemsetAsync((char*)d_ws + WS_CTL, 0, 16384, stream) != hipSuccess) { fprintf(stderr, "memset failed\n"); return; }
    Args a{};
    for (int i = 0; i < 34; ++i) a.in[i] = d_in[i];
    a.out = (float*)d_out; a.ws = (unsigned char*)d_ws; a.probe = PROBE_BITS;
    void* kargs[] = {&a};
    hipError_t e = hipLaunchCooperativeKernel((const void*)fwd_kernel, dim3(grid), dim3(512), kargs, LDS_BYTES, stream);
    if (e != hipSuccess) fprintf(stderr, "cooperative launch failed: %s (grid %d)\n", hipGetErrorString(e), grid);
}
```

```cpp
#include <hip/hip_runtime.h>
#include <hip/hip_cooperative_groups.h>
#include <cstdio>
#include <cstdint>
namespace cg = cooperative_groups;
#ifndef PROBE_BITS
#define PROBE_BITS 0
#endif

#define LAS __attribute__((address_space(3)))
typedef unsigned short bf16_t;
typedef short bf16x8 __attribute__((ext_vector_type(8)));
typedef short s16x4 __attribute__((ext_vector_type(4)));
typedef float f32x2 __attribute__((ext_vector_type(2)));
typedef float f32x4 __attribute__((ext_vector_type(4)));
typedef float f32x16 __attribute__((ext_vector_type(16)));
typedef unsigned u32x2 __attribute__((ext_vector_type(2)));
typedef unsigned u32x4 __attribute__((ext_vector_type(4)));
typedef __bf16 nbf16x2 __attribute__((ext_vector_type(2)));
#define DI __device__ __forceinline__
#define SCHED_B __builtin_amdgcn_sched_barrier(0)

constexpr int T = 16384, S = 4096, NB = 4, D = 1024;
constexpr int DFF = 2816;
constexpr float EPS = 1e-6f;
constexpr float LOG2E = 1.4426950408889634f;

constexpr size_t MiB = 1u << 20;
constexpr size_t WS_SS = 0;
constexpr size_t WS_CTL = 6 * MiB + 512 * 1024;
constexpr size_t WS_PB = 7 * MiB;
constexpr size_t WS_WATT = 15 * MiB;
constexpr size_t WS_WFFN = 26 * MiB;
constexpr size_t WS_X = 47 * MiB;
constexpr size_t WS_Y = 81 * MiB;
constexpr size_t WS_R3 = 114 * MiB;
constexpr size_t WS_R4 = 244 * MiB;
constexpr size_t WS_CS = 340 * MiB;
constexpr size_t WS_END = 344 * MiB;
constexpr int SS_IN = 0, SS_H1 = 16, SS_H2 = 32, SS_CQ = 48, SS_CKV = 56;

constexpr int RING_BYTES = 131072;
constexpr int XCH_OFF = RING_BYTES;
constexpr int LUT_OFF = RING_BYTES + 8192;
constexpr int KPOS_OFF = LUT_OFF + 1024;
constexpr int BARST_OFF = KPOS_OFF + 1024;
constexpr int LDS_BYTES = 147456;

DI unsigned pk2(float a, float b) { f32x2 v = {a, b}; nbf16x2 r = __builtin_convertvector(v, nbf16x2); return __builtin_bit_cast(unsigned, r); }
DI float bf_lo(unsigned u) { return __builtin_bit_cast(float, u << 16); }
DI float bf_hi(unsigned u) { return __builtin_bit_cast(float, u & 0xffff0000u); }
DI int lane_asm();
DI float shx(float v, int mask, int ln) { return __builtin_bit_cast(float, __builtin_amdgcn_ds_bpermute((ln ^ mask) << 2, __builtin_bit_cast(int, v))); }
DI int shxi(int v, int mask, int ln) { return __builtin_amdgcn_ds_bpermute((ln ^ mask) << 2, v); }
DI float shl(float v, int src) { return __builtin_bit_cast(float, __builtin_amdgcn_ds_bpermute(src << 2, __builtin_bit_cast(int, v))); }
template <int N> DI float dpp_ror(float v) { return __builtin_bit_cast(float, __builtin_amdgcn_update_dpp(0, __builtin_bit_cast(int, v), 0x120 + N, 0xF, 0xF, false)); }
DI float wave_sum(float v, int ln) {
#pragma unroll
    for (int o = 1; o < 64; o <<= 1) v += shx(v, o, ln);
    return v;
}
DI float rsq(float x) { return 1.0f / sqrtf(x); }
DI int lane_asm() { int l; asm volatile("v_mbcnt_lo_u32_b32 %0, -1, 0\n\tv_mbcnt_hi_u32_b32 %0, -1, %0" : "=v"(l)); return l; }

namespace pg8 {
constexpr int BM = 256, BK = 64, HALF = 128, HTB = HALF * BK * 2, NXCD = 8, WGM = 8;
__host__ __device__ __forceinline__ int lds_byte(int r, int c) { const int st = (r >> 4) * 2 + (c >> 5), rr = r & 15, cc = c & 31, ob = rr * 64 + cc * 2; return st * 1024 + (ob ^ (((ob >> 9) & 1) << 5)); }
__host__ __device__ __forceinline__ void stage_rc(int b, int& R, int& C) { const int st = b / 1024, sb = b % 1024, swz = sb ^ (((sb >> 9) & 1) << 5); R = (st >> 1) * 16 + swz / 64; C = (st & 1) * 32 + (swz % 64) / 2; }

__host__ __device__ __forceinline__ int perm32(int rho) { const int n = rho >> 4, i = rho & 15; return 8 * (i >> 2) + 4 * n + (i & 3); }
struct Unit { int pm, pn; };
struct Gemm { const bf16_t* A; const bf16_t* Bt; int K; int ovl; };
DI long a_row0(const Gemm& g, int pm) { return g.ovl ? (long)(pm / 17) * S + 254 * (pm % 17) - 2 : (long)pm * BM; }

struct StaticOrder {
    int nM, nN, nwg, G, c;
    DI void init(int nM_, int nN_, int G_, int c_) { nM = nM_; nN = nN_; nwg = nM * nN; G = G_; c = c_; }
    DI bool next(int i, Unit& u) const {
        const long L = (long)i * G + c; if (L >= nwg) return false;
        int wgid = (int)L; { const int q = nwg / NXCD, r = nwg % NXCD, xcd = wgid % NXCD, off = wgid / NXCD; wgid = (xcd < r ? xcd * (q + 1) : r * (q + 1) + (xcd - r) * q) + off; }
        const int nig = WGM * nN, gid = wgid / nig, fm = gid * WGM, gsz = (nM - fm) < WGM ? (nM - fm) : WGM;
        u.pm = fm + ((wgid % nig) % gsz); u.pn = (wgid % nig) / gsz; return true;
    }
};

template <class Epi, bool ALIGN_EPI>
DI void gemm_phase1(LAS unsigned char* lds, const Gemm g, const StaticOrder& Sd, const Epi& E, const int wid_in, const int dry) {
    int wid = wid_in; asm volatile("" : "+s"(wid));
    const int lane = lane_asm(), tid = wid * 64 + lane;
    const int wr = wid >> 2, wc = wid & 3, fr = lane & 15, fq = lane >> 4;
    int K = g.K; asm volatile("" : "+s"(K));
    const int nt = K / BK;
    unsigned voffA[2], voffB[2];
#pragma unroll
    for (int i = 0; i < 2; ++i) { int R, C; stage_rc(tid * 16 + i * 8192, R, C); const int Rb = Epi::PERM ? ((R & ~31) + perm32(R & 31)) : R; voffB[i] = (unsigned)(Rb * K + C) * 2u;
        const int Ra = g.ovl ? ((R & 64) | ((R & 15) << 2) | ((R >> 4) & 3)) : R;
        voffA[i] = (unsigned)(Ra * K + C) * 2u; }
    const size_t kstep = (size_t)(BK * 2);
    const size_t hstep = (size_t)HALF * K * 2;
    const size_t tstep = 2 * hstep;
    const size_t rowb = (size_t)K * 2;
    const unsigned ldsw = (unsigned)wid * 1024u;
    const int aoff = lds_byte(wr * 64 + fr, fq * 8), boff = lds_byte(wc * 32 + fr, fq * 8);
#define PG8_SA(b, h) (((b) * 2 + (h)) * HTB)
#define PG8_SB(b, h) ((4 + (b) * 2 + (h)) * HTB)
#define PG8_STAGE(bufoff, gbase, voff) do { _Pragma("unroll") for (int _i = 0; _i < 2; ++_i) \
        __builtin_amdgcn_global_load_lds((const unsigned*)((const char*)(gbase) + (voff)[_i]), (LAS unsigned*)(lds + (bufoff) + ldsw + _i * 8192), 16, 0, 0); } while (0)
#define PG8_LDA(dst, b, h) do { _Pragma("unroll") for (int m = 0; m < 4; ++m) _Pragma("unroll") for (int k = 0; k < 2; ++k) dst[m][k] = *(const LAS bf16x8*)(lds + PG8_SA(b, h) + aoff + m * 2048 + k * 1024); } while (0)
#define PG8_LDB(dst, b, h) do { _Pragma("unroll") for (int n = 0; n < 2; ++n) _Pragma("unroll") for (int k = 0; k < 2; ++k) dst[n][k] = *(const LAS bf16x8*)(lds + PG8_SB(b, h) + boff + n * 2048 + k * 1024); } while (0)
#define PG8_MMA(ai, bj, At, Bt) do { __builtin_amdgcn_s_setprio(1); _Pragma("unroll") for (int m = 0; m < 4; ++m) _Pragma("unroll") for (int n = 0; n < 2; ++n) _Pragma("unroll") for (int k = 0; k < 2; ++k) \
        acc[ai][bj][m][n] = __builtin_amdgcn_mfma_f32_16x16x32_bf16(Bt[n][k], At[m][k], acc[ai][bj][m][n], 0, 0, 0); __builtin_amdgcn_s_setprio(0); } while (0)
#define PG8_WAIT_V(n) asm volatile("s_waitcnt vmcnt(" #n ")" ::: "memory")
#define PG8_WAIT_L(n) asm volatile("s_waitcnt lgkmcnt(" #n ")" ::: "memory")
#define PG8_BAR __builtin_amdgcn_s_barrier()
#define PG8_SCHED __builtin_amdgcn_sched_barrier(0)
    Unit cur, nxt; int ui = 0;
    if (!Sd.next(0, cur)) return;
    f32x4 acc[2][2][4][2];
#pragma unroll
    for (int a = 0; a < 2; ++a)
#pragma unroll
        for (int b = 0; b < 2; ++b)
#pragma unroll
            for (int m = 0; m < 4; ++m)
#pragma unroll
                for (int n = 0; n < 2; ++n) acc[a][b][m][n] = (f32x4){0.f, 0.f, 0.f, 0.f};
    bf16x8 At[4][2], B0[2][2], B1[2][2];
    const char* cA = (const char*)g.A + a_row0(g, cur.pm) * (long)rowb; const char* cB = (const char*)g.Bt + (size_t)cur.pn * tstep;
    {
        PG8_STAGE(PG8_SB(0, 0), cB, voffB); PG8_STAGE(PG8_SB(0, 1), cB + hstep, voffB); PG8_STAGE(PG8_SA(0, 0), cA, voffA); PG8_STAGE(PG8_SA(0, 1), cA + hstep, voffA);
        if (wr == 1) PG8_BAR;
        PG8_WAIT_V(2); PG8_BAR;
        PG8_STAGE(PG8_SB(1, 0), cB + kstep, voffB); PG8_STAGE(PG8_SA(1, 0), cA + kstep, voffA); PG8_STAGE(PG8_SB(1, 1), cB + hstep + kstep, voffB);
        PG8_WAIT_V(6); PG8_BAR;
    }
    for (;;) {
        const bool has_next = Sd.next(ui + 1, nxt);
        const char* nA = has_next ? (const char*)g.A + a_row0(g, nxt.pm) * (long)rowb : cA; const char* nB = has_next ? (const char*)g.Bt + (size_t)nxt.pn * tstep : cB;
        for (int t = 0; t < nt; t += 2) {
            const bool last = (t == nt - 2);
            const char* a1 = cA + (size_t)(t + 1) * kstep;
            const char* a2 = last ? nA : cA + (size_t)(t + 2) * kstep; const char* b2 = last ? nB : cB + (size_t)(t + 2) * kstep;
            const char* a3 = a2 + kstep; const char* b3 = b2 + kstep;
            PG8_LDB(B0, 0, 0); PG8_LDB(B1, 0, 1); PG8_SCHED; PG8_LDA(At, 0, 0); PG8_STAGE(PG8_SA(1, 1), a1 + hstep, voffA);
            PG8_WAIT_V(8); PG8_WAIT_L(0); PG8_BAR; PG8_MMA(0, 0, At, B0); PG8_MMA(0, 1, At, B1); PG8_BAR; PG8_SCHED;
            PG8_LDA(At, 0, 1); PG8_STAGE(PG8_SB(0, 0), b2, voffB); PG8_STAGE(PG8_SB(0, 1), b2 + hstep, voffB); PG8_STAGE(PG8_SA(0, 0), a2, voffA);
            PG8_WAIT_V(8); PG8_WAIT_L(0); PG8_BAR; PG8_MMA(1, 0, At, B0); PG8_MMA(1, 1, At, B1); PG8_BAR; PG8_SCHED;
            PG8_LDB(B0, 1, 0); PG8_LDB(B1, 1, 1); PG8_SCHED; PG8_LDA(At, 1, 0); PG8_STAGE(PG8_SA(0, 1), a2 + hstep, voffA);
            PG8_WAIT_V(8); PG8_WAIT_L(0); PG8_BAR; PG8_MMA(0, 0, At, B0); PG8_MMA(0, 1, At, B1); PG8_BAR; PG8_SCHED;
            PG8_LDA(At, 1, 1); PG8_STAGE(PG8_SB(1, 0), b3, voffB); PG8_STAGE(PG8_SB(1, 1), b3 + hstep, voffB); PG8_STAGE(PG8_SA(1, 0), a3, voffA);
            PG8_WAIT_V(8); PG8_WAIT_L(0); PG8_BAR; PG8_MMA(1, 0, At, B0); PG8_MMA(1, 1, At, B1); PG8_BAR; PG8_SCHED;
        }
        if constexpr (ALIGN_EPI) { if (wr == 0) PG8_BAR; }
        { int fr_ = fr, fq_ = fq; asm volatile("" : "+v"(fr_), "+v"(fq_)); E(acc, cur, wr, wc, fr_, fq_, dry != 0); }
        if (!has_next) break;
#pragma unroll
        for (int a = 0; a < 2; ++a)
#pragma unroll
            for (int b = 0; b < 2; ++b)
#pragma unroll
                for (int m = 0; m < 4; ++m)
#pragma unroll
                    for (int n = 0; n < 2; ++n) acc[a][b][m][n] = (f32x4){0.f, 0.f, 0.f, 0.f};
        cur = nxt; cA = nA; cB = nB; ++ui;
        if constexpr (ALIGN_EPI) { if (wr == 1) PG8_BAR; }
    }
    PG8_WAIT_V(0);
    if constexpr (!ALIGN_EPI) { if (wr == 0) PG8_BAR; }
    PG8_BAR;
#undef PG8_SA
#undef PG8_SB
#undef PG8_STAGE
#undef PG8_LDA
#undef PG8_LDB
#undef PG8_MMA
#undef PG8_WAIT_V
#undef PG8_WAIT_L
#undef PG8_BAR
#undef PG8_SCHED
}
template <class Epi, bool ALIGN_EPI>
DI void gemm_phase(LAS unsigned char* lds, const Gemm g, const StaticOrder& Sd, const Epi& E, const int wid, const int nrep = 1, const long pflag = 0) {
    for (int rep = 0; rep < nrep; ++rep) gemm_phase1<Epi, ALIGN_EPI>(lds, g, Sd, E, wid, (rep < nrep - 1) && pflag != 0);
}
}
using pg8::Unit;
typedef f32x4 AccT[2][2][4][2];

DI int vperm16(int k) { return ((k >> 2) & 1) * 8 + (k >> 3) * 4 + (k & 3); }
DI void store_bf4(bf16_t* p, f32x4 v) { u32x2 w; w.x = pk2(v[0], v[1]); w.y = pk2(v[2], v[3]); *(u32x2*)p = w; }
DI float dot4(f32x4 v) { return (v[0] * v[0] + v[1] * v[1]) + (v[2] * v[2] + v[3] * v[3]); }

DI float sum16(const float* p) { const f32x4 a = *(const f32x4*)p, b = *(const f32x4*)(p + 4), c = *(const f32x4*)(p + 8), d = *(const f32x4*)(p + 12);
    return (((a[0] + a[1]) + (a[2] + a[3])) + ((b[0] + b[1]) + (b[2] + b[3]))) + (((c[0] + c[1]) + (c[2] + c[3])) + ((d[0] + d[1]) + (d[2] + d[3]))); }
DI float sum16c(const float* p, int fq, int ln) { const f32x4 a = *(const f32x4*)(p + fq * 4); float t = (a[0] + a[1]) + (a[2] + a[3]); t += shx(t, 16, ln); t += shx(t, 32, ln); return t; }
DI float sum8(const float* p) { const f32x4 a = *(const f32x4*)p, b = *(const f32x4*)(p + 4); return ((a[0] + a[1]) + (a[2] + a[3])) + ((b[0] + b[1]) + (b[2] + b[3])); }
DI float sum4(const float* p) { const f32x4 a = *(const f32x4*)p; return (a[0] + a[1]) + (a[2] + a[3]); }
struct EpiRes {
    static constexpr bool PERM = true;
    bf16_t* hb; float* ss;
    DI void operator()(AccT& acc, const Unit& u, int wr, int wc, int fr, int fq, const bool dry) const {
#pragma unroll
        for (int ai = 0; ai < 2; ++ai)
#pragma unroll
            for (int m = 0; m < 4; ++m) {
                const size_t row = (size_t)u.pm * 256 + ai * 128 + wr * 64 + m * 16 + fr; float sq = 0.f;
#pragma unroll
                for (int bj = 0; bj < 2; ++bj) {
                    const size_t off = row * D + u.pn * 256 + bj * 128 + wc * 32 + fq * 8;
                    const u32x4 hw = *(const u32x4*)(hb + off);
                    const f32x4 v0 = (f32x4){bf_lo(hw.x), bf_hi(hw.x), bf_lo(hw.y), bf_hi(hw.y)} + acc[ai][bj][m][0];
                    const f32x4 v1 = (f32x4){bf_lo(hw.z), bf_hi(hw.z), bf_lo(hw.w), bf_hi(hw.w)} + acc[ai][bj][m][1];
                    u32x4 o; o.x = pk2(v0[0], v0[1]); o.y = pk2(v0[2], v0[3]); o.z = pk2(v1[0], v1[1]); o.w = pk2(v1[2], v1[3]);
                    *(u32x4*)(hb + off) = dry ? hw : o;
                    sq += dot4(v0) + dot4(v1);
                }
                sq += shx(sq, 16, fq * 16 + fr); sq += shx(sq, 32, fq * 16 + fr);
                if (fq == 0 && !dry) ss[row * 16 + u.pn * 4 + wc] = sq;
            }
    }
};
struct EpiPlain {
    static constexpr bool PERM = true;
    bf16_t* out;
    DI void operator()(AccT& acc, const Unit& u, int wr, int wc, int fr, int fq, const bool dry) const {
#pragma unroll
        for (int ai = 0; ai < 2; ++ai)
#pragma unroll
            for (int m = 0; m < 4; ++m) {
                const size_t row = (size_t)u.pm * 256 + ai * 128 + wr * 64 + m * 16 + fr;
#pragma unroll
                for (int bj = 0; bj < 2; ++bj) { const f32x4 v0 = acc[ai][bj][m][0], v1 = acc[ai][bj][m][1];
                    u32x4 o; o.x = pk2(v0[0], v0[1]); o.y = pk2(v0[2], v0[3]); o.z = pk2(v1[0], v1[1]); o.w = pk2(v1[2], v1[3]);
                    *(u32x4*)(out + row * D + u.pn * 256 + bj * 128 + wc * 32 + fq * 8) = o; }
            }
    }
};
struct EpiPle {
    static constexpr bool PERM = true;
    const bf16_t* hin; bf16_t* ot; float* outf; const float* ss_in; float* ss_out;
    DI void operator()(AccT& acc, const Unit& u, int wr, int wc, int fr, int fq, const bool dry) const {
        float rsv[2][4];
#pragma unroll
        for (int ai = 0; ai < 2; ++ai)
#pragma unroll
            for (int m = 0; m < 4; ++m) { const size_t row = (size_t)u.pm * 256 + ai * 128 + wr * 64 + m * 16 + fr; rsv[ai][m] = rsq(sum16c(ss_in + row * 16, fq, fq * 16 + fr) * (1.0f / D) + EPS); }
#pragma unroll
        for (int ai = 0; ai < 2; ++ai)
#pragma unroll
            for (int m = 0; m < 4; ++m) {
                const size_t row = (size_t)u.pm * 256 + ai * 128 + wr * 64 + m * 16 + fr; float sq = 0.f;
                const float rs = rsv[ai][m];
#pragma unroll
                for (int bj = 0; bj < 2; ++bj) {
                    const size_t off = row * D + u.pn * 256 + bj * 128 + wc * 32 + fq * 8;
                    const u32x4 pw = *(const u32x4*)(ot + off), hw = *(const u32x4*)(hin + off);
                    const f32x4 pp0 = {bf_lo(pw.x), bf_hi(pw.x), bf_lo(pw.y), bf_hi(pw.y)}, pp1 = {bf_lo(pw.z), bf_hi(pw.z), bf_lo(pw.w), bf_hi(pw.w)};
                    f32x4 v0 = {bf_lo(hw.x), bf_hi(hw.x), bf_lo(hw.y), bf_hi(hw.y)}, v1 = {bf_lo(hw.z), bf_hi(hw.z), bf_lo(hw.w), bf_hi(hw.w)};
                    const f32x4 g0 = acc[ai][bj][m][0] * rs, g1 = acc[ai][bj][m][1] * rs;
#pragma unroll
                    for (int e = 0; e < 4; ++e) { v0[e] += pp0[e] * __builtin_amdgcn_rcpf(1.0f + __builtin_amdgcn_exp2f(-LOG2E * g0[e])); v1[e] += pp1[e] * __builtin_amdgcn_rcpf(1.0f + __builtin_amdgcn_exp2f(-LOG2E * g1[e])); }
                    if (outf) { if (!dry) { *(f32x4*)(outf + off) = v0; *(f32x4*)(outf + off + 4) = v1; } }
                    else { u32x4 o; o.x = pk2(v0[0], v0[1]); o.y = pk2(v0[2], v0[3]); o.z = pk2(v1[0], v1[1]); o.w = pk2(v1[2], v1[3]); *(u32x4*)(ot + off) = dry ? pw : o; }
                    sq += dot4(v0) + dot4(v1);
                }
                if (ss_out) { sq += shx(sq, 16, fq * 16 + fr); sq += shx(sq, 32, fq * 16 + fr); if (fq == 0 && !dry) ss_out[row * 16 + u.pn * 4 + wc] = sq; }
            }
    }
};
struct EpiQkvA {
    static constexpr bool PERM = true;
    const float* ss_in; const float* qg; const float* kg; bf16_t* Q; bf16_t* Kb; bf16_t* Vt;
    DI void operator()(AccT& acc, const Unit& u, int wr, int wc, int fr, int fq, const bool dry) const {
        const float live = dry ? 0.f : 1.f; (void)live;
        const int L = u.pn * 256 + wc * 64;
        float rsv[2][4];
#pragma unroll
        for (int ai = 0; ai < 2; ++ai)
#pragma unroll
            for (int m = 0; m < 4; ++m) { const size_t row = (size_t)u.pm * 256 + ai * 128 + wr * 64 + m * 16 + fr; rsv[ai][m] = rsq(sum16c(ss_in + row * 16, fq, fq * 16 + fr) * (1.0f / D) + EPS); }
#pragma unroll
        for (int ai = 0; ai < 2; ++ai)
#pragma unroll
            for (int m = 0; m < 4; ++m) {
                const size_t row = (size_t)u.pm * 256 + ai * 128 + wr * 64 + m * 16 + fr;
                const float rs = rsv[ai][m];
                if (u.pn < 8) {
                    float sq = 0.f;
#pragma unroll
                    for (int bj = 0; bj < 2; ++bj)
#pragma unroll
                        for (int n = 0; n < 2; ++n) { acc[ai][bj][m][n] *= rs; sq += dot4(acc[ai][bj][m][n]); }
                    sq += shx(sq, 16, fq * 16 + fr); sq += shx(sq, 32, fq * 16 + fr);
                    float rg = rsq(sq * (1.0f / 64.0f) + EPS);
                    const float* gp = (u.pn < 4) ? qg : kg; if (u.pn < 4) rg *= 0.125f * LOG2E;
                    bf16_t* dst = (u.pn < 4) ? Q + row * 1024 + L : Kb + row * 1024 + (L - 1024);
#pragma unroll
                    for (int bj = 0; bj < 2; ++bj) { const int d = 32 * bj + 8 * fq; const f32x4 g0 = *(const f32x4*)(gp + d), g1 = *(const f32x4*)(gp + d + 4);
                        { const f32x4 a_ = acc[ai][bj][m][0] * g0 * rg, b_ = acc[ai][bj][m][1] * g1 * rg; u32x4 o_; o_.x = pk2(a_[0], a_[1]); o_.y = pk2(a_[2], a_[3]); o_.z = pk2(b_[0], b_[1]); o_.w = pk2(b_[2], b_[3]); *(u32x4*)(dst + d) = o_; } }
                } else {
                    const int b = (int)(row >> 12), s_ = (int)(row & 4095), s = (s_ & ~15) | vperm16(s_ & 15);
#pragma unroll
                    for (int bj = 0; bj < 2; ++bj)
#pragma unroll
                        for (int n = 0; n < 2; ++n) {
                            const int lv = L - 2048 + 32 * bj + 8 * fq + 4 * n;
                            bf16_t* p = Vt + ((size_t)b * 1024 + lv) * S + s;
                            const f32x4 v = acc[ai][bj][m][n] * rs;
                            const unsigned w0 = pk2(v[0], v[1]), w1 = pk2(v[2], v[3]);
                            p[0] = (bf16_t)(w0 & 0xffff); p[S] = (bf16_t)(w0 >> 16); p[2 * S] = (bf16_t)(w1 & 0xffff); p[3 * S] = (bf16_t)(w1 >> 16);
                            SCHED_B;
                        }
                }
                SCHED_B;
            }
    }
};
struct EpiDq {
    static constexpr bool PERM = true;
    const float* ss_in; bf16_t* cq; bf16_t* ckv; bf16_t* Kpe; const float* gpe; const f32x2* cst; float* ss_cq; float* ss_ckv;
    DI void operator()(AccT& acc, const Unit& u, int wr, int wc, int fr, int fq, const bool dry) const {
        float rsv[2][4];
#pragma unroll
        for (int ai = 0; ai < 2; ++ai)
#pragma unroll
            for (int m = 0; m < 4; ++m) { const size_t row = (size_t)u.pm * 256 + ai * 128 + wr * 64 + m * 16 + fr; rsv[ai][m] = rsq(sum16c(ss_in + row * 16, fq, fq * 16 + fr) * (1.0f / D) + EPS); }
#pragma unroll
        for (int ai = 0; ai < 2; ++ai)
#pragma unroll
            for (int m = 0; m < 4; ++m) {
                const size_t row = (size_t)u.pm * 256 + ai * 128 + wr * 64 + m * 16 + fr;
                const float rs = rsv[ai][m]; float sq = 0.f;
                if (u.pn < 3) {
#pragma unroll
                    for (int bj = 0; bj < 2; ++bj) {
                        const int c = bj * 128 + wc * 32 + fq * 8; const f32x4 v0 = acc[ai][bj][m][0] * rs, v1 = acc[ai][bj][m][1] * rs;
                        bf16_t* dp = (u.pn < 2) ? cq + row * 512 + u.pn * 256 + c : ckv + row * 256 + c;
                        { const f32x4 a_ = v0, b_ = v1; u32x4 o_; o_.x = pk2(a_[0], a_[1]); o_.y = pk2(a_[2], a_[3]); o_.z = pk2(b_[0], b_[1]); o_.w = pk2(b_[2], b_[3]); *(u32x4*)(dp) = o_; }
                        sq += dot4(v0) + dot4(v1);
                    }
                    sq += shx(sq, 16, fq * 16 + fr); sq += shx(sq, 32, fq * 16 + fr);
                    if (fq == 0 && !dry) { if (u.pn < 2) ss_cq[row * 8 + u.pn * 4 + wc] = sq; else ss_ckv[row * 4 + wc] = sq; }
                } else if (wc == 0) {
#pragma unroll
                    for (int bj = 0; bj < 2; ++bj)
#pragma unroll
                        for (int n = 0; n < 2; ++n) { acc[ai][bj][m][n] *= rs; sq += dot4(acc[ai][bj][m][n]); }
                    sq += shx(sq, 16, fq * 16 + fr); sq += shx(sq, 32, fq * 16 + fr);
                    const float rg = rsq(sq * (1.0f / 64.0f) + EPS);
#pragma unroll
                    for (int n = 0; n < 2; ++n) {
                        const int d = fq * 8 + n * 4;
                        const f32x4 g1 = *(const f32x4*)(gpe + d), g2 = *(const f32x4*)(gpe + 32 + d);
                        const f32x4 c01 = *(const f32x4*)(cst + row * 32 + d), c23 = *(const f32x4*)(cst + row * 32 + d + 2);
                        const f32x4 y1 = acc[ai][0][m][n] * g1 * rg, y2 = acc[ai][1][m][n] * g2 * rg;
                        const f32x4 cs = {c01[0], c01[2], c23[0], c23[2]}, sn = {c01[1], c01[3], c23[1], c23[3]};
                        store_bf4(Kpe + row * 64 + d, y1 * cs - y2 * sn); store_bf4(Kpe + row * 64 + 32 + d, y1 * sn + y2 * cs);
                    }
                }
            }
    }
};
struct EpiUq {
    static constexpr bool PERM = true;
    const float* ss_cq; bf16_t* Qn; bf16_t* Qp; const float* gqn; const float* gqp; const f32x2* cst; LAS float* xch;
    DI void operator()(AccT& acc, const Unit& u, int wr, int wc, int fr, int fq, const bool dry) const {
        const float scq = 0.07216878364870322f * LOG2E;
        const int ln = fq * 16 + fr;
        if (u.pn < 8) {
#pragma unroll
            for (int ai = 0; ai < 2; ++ai)
#pragma unroll
                for (int m = 0; m < 4; ++m) {
                    const int rl = ai * 128 + wr * 64 + m * 16 + fr; const size_t row = (size_t)u.pm * 256 + rl;
                    const float rs = rsq(sum8(ss_cq + row * 8) * (1.0f / 512.0f) + EPS);
#pragma unroll
                    for (int bj = 0; bj < 2; ++bj) {
                        float sq = 0.f;
#pragma unroll
                        for (int n = 0; n < 2; ++n) { acc[ai][bj][m][n] *= rs; sq += dot4(acc[ai][bj][m][n]); }
                        sq += shx(sq, 16, ln); sq += shx(sq, 32, ln);
                        if (fq == 0) xch[(rl * 2 + bj) * 4 + wc] = sq;
                    }
                }
            asm volatile("s_waitcnt lgkmcnt(0)" ::: "memory"); __builtin_amdgcn_s_barrier(); asm volatile("" ::: "memory");
#pragma unroll
            for (int ai = 0; ai < 2; ++ai)
#pragma unroll
                for (int m = 0; m < 4; ++m) {
                    const int rl = ai * 128 + wr * 64 + m * 16 + fr; const size_t row = (size_t)u.pm * 256 + rl;
#pragma unroll
                    for (int bj = 0; bj < 2; ++bj) {
                        const f32x4 pt = *(const LAS f32x4*)(xch + (rl * 2 + bj) * 4);
                        const float rg = rsq(((pt[0] + pt[1]) + (pt[2] + pt[3])) * (1.0f / 128.0f) + EPS) * scq;
                        { const int c = wc * 32 + fq * 8; const f32x4 g0 = *(const f32x4*)(gqn + c), g1 = *(const f32x4*)(gqn + c + 4);
                            { const f32x4 a_ = acc[ai][bj][m][0] * g0 * rg, b_ = acc[ai][bj][m][1] * g1 * rg; u32x4 o_; o_.x = pk2(a_[0], a_[1]); o_.y = pk2(a_[2], a_[3]); o_.z = pk2(b_[0], b_[1]); o_.w = pk2(b_[2], b_[3]); *(u32x4*)(Qn + row * 2048 + (2 * u.pn + bj) * 128 + c) = o_; } }
                    }
                }
        } else {
            const int head = (u.pn - 8) * 4 + wc;
#pragma unroll
            for (int ai = 0; ai < 2; ++ai)
#pragma unroll
                for (int m = 0; m < 4; ++m) {
                    const size_t row = (size_t)u.pm * 256 + ai * 128 + wr * 64 + m * 16 + fr;
                    const float rs = rsq(sum8(ss_cq + row * 8) * (1.0f / 512.0f) + EPS); float sq = 0.f;
#pragma unroll
                    for (int bj = 0; bj < 2; ++bj)
#pragma unroll
                        for (int n = 0; n < 2; ++n) { acc[ai][bj][m][n] *= rs; sq += dot4(acc[ai][bj][m][n]); }
                    sq += shx(sq, 16, ln); sq += shx(sq, 32, ln);
                    const float rg = rsq(sq * (1.0f / 64.0f) + EPS) * scq;
#pragma unroll
                    for (int n = 0; n < 2; ++n) {
                        const int d = fq * 8 + n * 4;
                        const f32x4 g1 = *(const f32x4*)(gqp + d), g2 = *(const f32x4*)(gqp + 32 + d);
                        const f32x4 c01 = *(const f32x4*)(cst + row * 32 + d), c23 = *(const f32x4*)(cst + row * 32 + d + 2);
                        const f32x4 y1 = acc[ai][0][m][n] * g1 * rg, y2 = acc[ai][1][m][n] * g2 * rg;
                        const f32x4 cs = {c01[0], c01[2], c23[0], c23[2]}, sn = {c01[1], c01[3], c23[1], c23[3]};
                        store_bf4(Qp + row * 1024 + head * 64 + d, y1 * cs - y2 * sn); store_bf4(Qp + row * 1024 + head * 64 + 32 + d, y1 * sn + y2 * cs);
                    }
                }
        }
    }
};
struct EpiUkv {
    static constexpr bool PERM = true;
    const float* ss_ckv; bf16_t* Kn; bf16_t* Vt; const float* gk; LAS float* xch;
    DI void operator()(AccT& acc, const Unit& u, int wr, int wc, int fr, int fq, const bool dry) const {
        const int ln = fq * 16 + fr;
#pragma unroll
        for (int ai = 0; ai < 2; ++ai)
#pragma unroll
            for (int m = 0; m < 4; ++m) {
                const int rl = ai * 128 + wr * 64 + m * 16 + fr; const size_t row = (size_t)u.pm * 256 + rl;
                const float rs = rsq(sum4(ss_ckv + row * 4) * (1.0f / 256.0f) + EPS); float sq = 0.f;
#pragma unroll
                for (int n = 0; n < 2; ++n) { acc[ai][0][m][n] *= rs; sq += dot4(acc[ai][0][m][n]); acc[ai][1][m][n] *= rs; }
                sq += shx(sq, 16, ln); sq += shx(sq, 32, ln);
                if (fq == 0) xch[rl * 4 + wc] = sq;
            }
        asm volatile("s_waitcnt lgkmcnt(0)" ::: "memory"); __builtin_amdgcn_s_barrier(); asm volatile("" ::: "memory");
#pragma unroll
        for (int ai = 0; ai < 2; ++ai)
#pragma unroll
            for (int m = 0; m < 4; ++m) {
                const int rl = ai * 128 + wr * 64 + m * 16 + fr; const size_t row = (size_t)u.pm * 256 + rl;
                const f32x4 pt = *(const LAS f32x4*)(xch + rl * 4);
                const float rg = rsq(((pt[0] + pt[1]) + (pt[2] + pt[3])) * (1.0f / 128.0f) + EPS);
                { const int c = wc * 32 + fq * 8; const f32x4 g0 = *(const f32x4*)(gk + c), g1 = *(const f32x4*)(gk + c + 4);
                    { const f32x4 a_ = acc[ai][0][m][0] * g0 * rg, b_ = acc[ai][0][m][1] * g1 * rg; u32x4 o_; o_.x = pk2(a_[0], a_[1]); o_.y = pk2(a_[2], a_[3]); o_.z = pk2(b_[0], b_[1]); o_.w = pk2(b_[2], b_[3]); *(u32x4*)(Kn + row * 2048 + u.pn * 128 + c) = o_; } }
            }
        const size_t row0 = (size_t)u.pm * 256 + wr * 64 + fr;
        const int b = (int)(row0 >> 12), s0_ = (int)(row0 & 4095), s0 = (s0_ & ~15) | vperm16(s0_ & 15);
        bf16_t* vb = Vt + ((size_t)(b * 16 + u.pn) * 128 + wc * 32 + fq * 8) * S + s0;
#pragma unroll
        for (int ai = 0; ai < 2; ++ai)
#pragma unroll
            for (int m = 0; m < 4; ++m)
#pragma unroll
                for (int n = 0; n < 2; ++n) {
                    bf16_t* p = vb + (size_t)(n * 4) * S + ai * 128 + m * 16;
                    const f32x4 v = acc[ai][1][m][n];
                    const unsigned w0 = pk2(v[0], v[1]), w1 = pk2(v[2], v[3]);
                    p[0] = (bf16_t)(w0 & 0xffff); p[S] = (bf16_t)(w0 >> 16); p[2 * S] = (bf16_t)(w1 & 0xffff); p[3 * S] = (bf16_t)(w1 >> 16);
                    SCHED_B;
                }
    }
};
struct EpiFfnIn {
    static constexpr bool PERM = true;
    const float* ss; const float* cw; const float* cb; bf16_t* act; LAS float* xch;
    template <int CTRL> static DI float dppo(float old, float v) { return __builtin_bit_cast(float, __builtin_amdgcn_update_dpp(__builtin_bit_cast(int, old), __builtin_bit_cast(int, v), CTRL, 0xF, 0xF, false)); }
    DI void operator()(AccT& acc, const Unit& u, int wr, int wc, int fr, int fq, const bool dry) const {
        const int bidx = u.pm / 17, sbase = 254 * (u.pm % 17) - 2;
#pragma unroll
        for (int ai = 0; ai < 2; ++ai)
#pragma unroll
            for (int m = 0; m < 4; ++m) {
                int s = sbase + ai * 128 + wr * 64 + fr * 4 + m; s = s < 0 ? 0 : (s > S - 1 ? S - 1 : s);
                const float rs = rsq(sum16c(ss + (size_t)(bidx * S + s) * 16, fq, fq * 16 + fr) * (1.0f / D) + EPS);
#pragma unroll
                for (int bj = 0; bj < 2; ++bj)
#pragma unroll
                    for (int n = 0; n < 2; ++n) acc[ai][bj][m][n] *= rs;
            }
        if (fr == 15) {
#pragma unroll
            for (int ai = 0; ai < 2; ++ai)
#pragma unroll
                for (int bj = 0; bj < 2; ++bj)
#pragma unroll
                    for (int n = 0; n < 2; ++n) {
                        LAS float* xp = xch + (2 * ai + wr) * 512 + bj * 128 + wc * 32 + n * 16 + fq * 4;
                        *(LAS f32x4*)xp = acc[ai][bj][2][n]; *(LAS f32x4*)(xp + 256) = acc[ai][bj][3][n];
                    }
        }
        asm volatile("s_waitcnt lgkmcnt(0)" ::: "memory"); __builtin_amdgcn_s_barrier(); asm volatile("" ::: "memory");
#pragma unroll
        for (int n = 0; n < 2; ++n) {
            const int cl = wc * 32 + n * 16 + fq * 4  , ch = u.pn * 128 + wc * 32 + fq * 8 + n * 4  ;
            const f32x4 wa0 = *(const f32x4*)(cw + ch), wa1 = *(const f32x4*)(cw + 2 * DFF + ch), wa2 = *(const f32x4*)(cw + 4 * DFF + ch), ba = *(const f32x4*)(cb + ch);
            const f32x4 wg0 = *(const f32x4*)(cw + DFF + ch), wg1 = *(const f32x4*)(cw + 3 * DFF + ch), wg2 = *(const f32x4*)(cw + 5 * DFF + ch), bg = *(const f32x4*)(cb + DFF + ch);
#pragma unroll
            for (int ai = 0; ai < 2; ++ai) {
                const int blk = 2 * ai + wr;
                f32x4 X0a = {0.f, 0.f, 0.f, 0.f}, X1a = X0a, X0g = X0a, X1g = X0a;
                if (blk > 0) { const LAS float* xb = xch + (blk - 1) * 512; X0a = *(const LAS f32x4*)(xb + cl); X1a = *(const LAS f32x4*)(xb + 256 + cl); X0g = *(const LAS f32x4*)(xb + 128 + cl); X1g = *(const LAS f32x4*)(xb + 256 + 128 + cl); }
                f32x4 q2a, q3a, q2g, q3g;
#pragma unroll
                for (int e = 0; e < 4; ++e) { q2a[e] = dppo<0x111>(X0a[e], acc[ai][0][2][n][e]); q3a[e] = dppo<0x111>(X1a[e], acc[ai][0][3][n][e]);
                                              q2g[e] = dppo<0x111>(X0g[e], acc[ai][1][2][n][e]); q3g[e] = dppo<0x111>(X1g[e], acc[ai][1][3][n][e]); }
                const f32x4 zero4 = {0.f, 0.f, 0.f, 0.f};
                const bool first = (sbase < 0) && (blk == 0) && (fr == 0);
#pragma unroll
                for (int m = 0; m < 4; ++m) {
                    const f32x4 ua = acc[ai][0][m][n], ug = acc[ai][1][m][n];
                    f32x4 p1a = (m == 0) ? q3a : acc[ai][0][m > 0 ? m - 1 : 0][n], p1g = (m == 0) ? q3g : acc[ai][1][m > 0 ? m - 1 : 0][n];
                    f32x4 p2a = (m == 0) ? q2a : (m == 1) ? q3a : acc[ai][0][m > 1 ? m - 2 : 0][n], p2g = (m == 0) ? q2g : (m == 1) ? q3g : acc[ai][1][m > 1 ? m - 2 : 0][n];
                    if (m == 2 && first) { p1a = zero4; p1g = zero4; p2a = zero4; p2g = zero4; }
                    if (m == 3 && first) { p2a = zero4; p2g = zero4; }
                    const f32x4 ca = ba + wa0 * p2a + wa1 * p1a + wa2 * ua;
                    const f32x4 cg_ = bg + wg0 * p2g + wg1 * p1g + wg2 * ug;
                    f32x4 o;
#pragma unroll
                    for (int e = 0; e < 4; ++e) o[e] = ca[e] * cg_[e] * __builtin_amdgcn_rcpf(1.0f + __builtin_amdgcn_exp2f(-LOG2E * cg_[e]));
                    const int Rt = ai * 128 + wr * 64 + fr * 4 + m, s = sbase + Rt;
                    if (Rt >= 2 && s < S) store_bf4(act + ((size_t)bidx * S + s) * DFF + ch, o);
                }
                SCHED_B;
            }
        }
    }
};

struct AttnArgs {
    const bf16_t* Q; const bf16_t* Q2; const bf16_t* K; const bf16_t* K2; const bf16_t* Vt; bf16_t* O;
    const int* pos; const float* ss_q; const float* gn; const float* gp; const f32x2* cs;
    int dry; const int* pmax; const float* rel; const float* lq1; const float* lk1; const float* lq2; const float* lk2; const float* subg; float lam_init;
};
DI int crow(int i, int h) { return (i & 3) + 8 * (i >> 2) + 4 * h; }
template <int SI> DI bf16x8 pack8(const f32x16& x) {
    u32x4 p; p.x = pk2(x[8 * SI], x[8 * SI + 1]); p.y = pk2(x[8 * SI + 2], x[8 * SI + 3]); p.z = pk2(x[8 * SI + 4], x[8 * SI + 5]); p.w = pk2(x[8 * SI + 6], x[8 * SI + 7]);
    return __builtin_bit_cast(bf16x8, p);
}
#define MFMA32(a, b, c) __builtin_amdgcn_mfma_f32_32x32x16_bf16((a), (b), (c), 0, 0, 0)

template <bool DIFF>
DI void attn_unit(const AttnArgs& a, LAS unsigned char* lds, int b, int head, int qb, const int wid_in) {
    int wid = wid_in; asm volatile("" : "+s"(wid));
    constexpr int DQK = DIFF ? 64 : 192, NKS = DQK / 16, KST = DQK * 2 + 16, KBYTES = 64 * KST, VST = 144, NH = DIFF ? 8 : 16;
    constexpr int NKL = DIFF ? 1 : 3;
    const int lane = lane_asm(), tid = wid * 64 + lane, r = lane & 31, h = lane >> 5;
    const int qw = qb * 256 + wid * 32, nt = (qb + 1) * 4, jlast = qw >> 5;
    const int pvar = PROBE_BITS ? (a.dry >> 1) : 0;
    const size_t tokq = (size_t)b * S + qw + r;
    LAS float* lut = (LAS float*)(lds + LUT_OFF);
    const int qpos = a.pos[tokq];
    int qpmin = qpos; unsigned long long nearA = 0, nearB = 0;
    float lam = 0.f;
    if constexpr (DIFF) {
#pragma unroll
        for (int o = 1; o < 64; o <<= 1) { const int t2 = shxi(qpmin, o, lane); qpmin = t2 < qpmin ? t2 : qpmin; }
        qpmin = __builtin_amdgcn_readfirstlane(qpmin);
        nearA = __builtin_amdgcn_ballot_w64(qpmin - a.pmax[b * 128 + lane] < 255); nearB = __builtin_amdgcn_ballot_w64(qpmin - a.pmax[b * 128 + 64 + lane] < 255);
        const float s1 = wave_sum(a.lq1[lane] * a.lk1[lane], lane), s2 = wave_sum(a.lq2[lane] * a.lk2[lane], lane);
        lam = expf(s1) - expf(s2) + a.lam_init;
    }
    f32x16 O[4];

    for (int c = 0; c < (DIFF ? 2 : 1); ++c) {
        bf16x8 qf[NKS];
        if constexpr (DIFF) {
#pragma unroll
            for (int ks = 0; ks < NKS; ++ks) qf[ks] = *(const bf16x8*)(a.Q + tokq * 1024 + head * 128 + c * 64 + ks * 16 + h * 8);
        } else {
#pragma unroll
            for (int ks = 0; ks < 8; ++ks) qf[ks] = *(const bf16x8*)(a.Q + tokq * 2048 + head * 128 + ks * 16 + h * 8);
#pragma unroll
            for (int ks = 0; ks < 4; ++ks) qf[8 + ks] = *(const bf16x8*)(a.Q2 + tokq * 1024 + head * 64 + ks * 16 + h * 8);
        }
        float mrun = 0.f, lrun = 0.f;
#pragma unroll
        for (int v = 0; v < 4; ++v)
#pragma unroll
            for (int i = 0; i < 16; ++i) O[v][i] = 0.f;

        constexpr int VBYTES = 128 * VST;
        u32x4 kreg[NKL], vreg[2]; int kpreg = 0;
        LAS int* kposl = (LAS int*)(lds + KPOS_OFF);
        auto load_tile = [&](int t) {
            const int key0 = t * 64;
            if constexpr (DIFF) {
                const int row = tid >> 3, cc = tid & 7;
                kreg[0] = *(const u32x4*)(a.K + ((size_t)b * S + key0 + row) * 1024 + head * 128 + c * 64 + cc * 8);
                if (tid < 64) kpreg = a.pos[(size_t)b * S + key0 + tid];
            } else {
                { const int row = tid >> 3, c8 = (tid & 7) * 8; const size_t tk = (size_t)b * S + key0 + row;
                    const bf16_t* kp_ = a.K + tk * 2048 + head * 128 + c8;
                    kreg[0] = *(const u32x4*)kp_; kreg[1] = *(const u32x4*)(kp_ + 64); kreg[2] = *(const u32x4*)(a.K2 + tk * 64 + c8); }
            }
#pragma unroll
            for (int i = 0; i < 2; ++i) { const int id = tid + 512 * i, vrow = id >> 3, cc = id & 7;
                vreg[i] = *(const u32x4*)(a.Vt + ((size_t)(b * NH + head) * 128 + vrow) * S + key0 + cc * 8); }
        };
        auto store_tile = [&](int kb, int vb) {
            LAS unsigned char* kp = lds + kb * KBYTES;
            if constexpr (DIFF) {
                const int row = tid >> 3, cc = tid & 7; *(LAS u32x4*)(kp + row * KST + cc * 16) = kreg[0];
                if (tid < 64) kposl[vb * 64 + tid] = kpreg;
            } else {
                { LAS unsigned char* kq = kp + (tid >> 3) * KST + (tid & 7) * 16; *(LAS u32x4*)kq = kreg[0]; *(LAS u32x4*)(kq + 128) = kreg[1]; *(LAS u32x4*)(kq + 256) = kreg[2]; }
            }
#pragma unroll
            for (int i = 0; i < 2; ++i) { const int id = tid + 512 * i, vrow = id >> 3, cc = id & 7;
                *(LAS u32x4*)(lds + 2 * KBYTES + vb * VBYTES + vrow * VST + cc * 16) = vreg[i]; }
        };
        f32x16 Sc;
        auto step = [&](const LAS unsigned char* Kn, const LAS unsigned char* Vb, const LAS int* kpl, int j) {
            if constexpr (DIFF) {
                if (((j < 64 ? nearA >> j : nearB >> (j - 64)) & 1ull) != 0) {
                    const LAS int* kpp = kpl + 4 * h;
#pragma unroll
                    for (int i = 0; i < 16; ++i) { int d0 = qpos - kpp[(i & 3) + 8 * (i >> 2)]; d0 = d0 < 0 ? 0 : (d0 > 255 ? 255 : d0); Sc[i] += lut[d0]; }
                }
            }
            if (j == jlast) {
                int r_ = r - 4 * h; asm volatile("" : "+v"(r_));
#pragma unroll
                for (int i = 0; i < 16; ++i) if ((i & 3) + 8 * (i >> 2) > r_) Sc[i] = -1e30f;
            }
            f32x16 Nx;
#pragma unroll
            for (int i = 0; i < 16; ++i) Nx[i] = 0.f;
#pragma unroll
            for (int ks = 0; ks < NKS; ++ks) { const bf16x8 a0 = *(const LAS bf16x8*)(Kn + r * KST + ks * 32 + h * 16); Nx = MFMA32(a0, qf[ks], Nx); }
            bf16x8 vf0, vf1, vf2, vf3, vf4, vf5, vf6, vf7;
            if constexpr (false) {
                const unsigned va = (unsigned)(size_t)Vb + (unsigned)(r * VST + h * 16);
                asm volatile("ds_read_b128 %0, %8\n\tds_read_b128 %1, %8 offset:32\n\tds_read_b128 %2, %8 offset:4608\n\tds_read_b128 %3, %8 offset:4640\n\t"
                             "ds_read_b128 %4, %8 offset:9216\n\tds_read_b128 %5, %8 offset:9248\n\tds_read_b128 %6, %8 offset:13824\n\tds_read_b128 %7, %8 offset:13856"
                             : "=&v"(vf0), "=&v"(vf1), "=&v"(vf2), "=&v"(vf3), "=&v"(vf4), "=&v"(vf5), "=&v"(vf6), "=&v"(vf7) : "v"(va) : "memory");
            }
            float mxr = 0.f;
            if (!(pvar & 2)) {
            float mx = Sc[0];
#pragma unroll
            for (int i = 1; i < 16; ++i) mx = fmaxf(mx, Sc[i]);
            mx = fmaxf(mx, shx(mx, 32, lane));
            mxr = mx - mrun;
            float ps = 0.f;
#pragma unroll
            for (int i = 0; i < 16; ++i) { Sc[i] = __builtin_amdgcn_exp2f(Sc[i] - mrun); ps += Sc[i]; }
            lrun += ps;
            }
            const bf16x8 p0 = pack8<0>(Sc), p1 = pack8<1>(Sc);
            if constexpr (false) {
                asm volatile("s_waitcnt lgkmcnt(0)" : "+v"(vf0), "+v"(vf1), "+v"(vf2), "+v"(vf3), "+v"(vf4), "+v"(vf5), "+v"(vf6), "+v"(vf7) :: "memory");
                O[0] = MFMA32(vf0, p0, O[0]); O[1] = MFMA32(vf2, p0, O[1]); O[2] = MFMA32(vf4, p0, O[2]); O[3] = MFMA32(vf6, p0, O[3]);
                O[0] = MFMA32(vf1, p1, O[0]); O[1] = MFMA32(vf3, p1, O[1]); O[2] = MFMA32(vf5, p1, O[2]); O[3] = MFMA32(vf7, p1, O[3]);
            } else {
#pragma unroll
                for (int v = 0; v < 4; ++v) {
                    const LAS unsigned char* vp = Vb + (v * 32 + r) * VST + h * 16;
                    O[v] = MFMA32(*(const LAS bf16x8*)vp, p0, O[v]);
                    O[v] = MFMA32(*(const LAS bf16x8*)(vp + 32), p1, O[v]);
                }
            }
            if (j == 0 || __builtin_amdgcn_ballot_w64(mxr > 8.0f) != 0) {
                const float dlt = (j == 0) ? mxr : fmaxf(mxr, 0.f), alpha = __builtin_amdgcn_exp2f(-dlt);
                mrun += dlt; lrun *= alpha;
#pragma unroll
                for (int v = 0; v < 4; ++v)
#pragma unroll
                    for (int i = 0; i < 16; ++i) O[v][i] *= alpha;
            }
            Sc = Nx;
        };
        load_tile(0);
        __syncthreads();
        if constexpr (DIFF) {
            if (c == 0 && tid < 256) {
                const int n = tid; int bk;
                if (n < 16) bk = n; else { const float lr = logf((float)n / 16.0f) / 2.0794415416798357f; bk = 16 + (int)(lr * 16.0f); bk = bk > 31 ? 31 : bk; }
                lut[n] = (a.rel[bk * 8 + head] - a.rel[31 * 8 + head]) * LOG2E;
            }
        }
        store_tile(0, 0);
        __syncthreads();
        if (nt > 1) load_tile(1);
        int vcur = 0, vprev = 2, vnxt = 1;
        for (int t = 0; t <= nt; ++t) {
            if (!(pvar & 1)) { if (t + 1 < nt) store_tile((t + 1) & 1, vnxt);
            if (t + 2 < nt) load_tile(t + 2); }
            SCHED_B;
            const LAS unsigned char* Kt = lds + (t & 1) * KBYTES;
            if (t == 0) {
#pragma unroll
                for (int i = 0; i < 16; ++i) Sc[i] = 0.f;
#pragma unroll
                for (int ks = 0; ks < NKS; ++ks) { const bf16x8 a0 = *(const LAS bf16x8*)(Kt + r * KST + ks * 32 + h * 16); Sc = MFMA32(a0, qf[ks], Sc); }
            } else if (2 * t - 1 <= jlast) {
                step(Kt, lds + 2 * KBYTES + vprev * VBYTES + 64, kposl + vprev * 64 + 32, 2 * t - 1);
            }
            if (t < nt && 2 * t <= jlast) step(Kt + 32 * KST, lds + 2 * KBYTES + vcur * VBYTES, kposl + vcur * 64, 2 * t);
            SCHED_B;
            if (!(pvar & 4)) { asm volatile("s_waitcnt lgkmcnt(0)" ::: "memory"); __builtin_amdgcn_s_barrier(); asm volatile("" ::: "memory"); }
            vprev = vcur; vcur = vnxt; vnxt = (vnxt == 2) ? 0 : vnxt + 1;
        }
        lrun += shx(lrun, 32, lane);
        const float inv = 1.0f / lrun;
        if constexpr (DIFF) {
            const int lane = lane_asm(), h = lane >> 5;
            LAS unsigned* stash = (LAS unsigned*)(lds + 73728 + wid * 8192) + lane;
            if (c == 0) {
#pragma unroll
                for (int v = 0; v < 4; ++v)
#pragma unroll
                    for (int i = 0; i < 8; ++i) stash[(v * 8 + i) * 64] = pk2(O[v][2 * i] * inv, O[v][2 * i + 1] * inv);
            } else {
                float sq = 0.f;
#pragma unroll
                for (int v = 0; v < 4; ++v)
#pragma unroll
                    for (int i = 0; i < 8; ++i) { const unsigned w = stash[(v * 8 + i) * 64];
                        O[v][2 * i] = bf_lo(w) - lam * (O[v][2 * i] * inv); O[v][2 * i + 1] = bf_hi(w) - lam * (O[v][2 * i + 1] * inv);
                        sq += O[v][2 * i] * O[v][2 * i] + O[v][2 * i + 1] * O[v][2 * i + 1]; if ((i & 3) == 3) SCHED_B; }
                sq += shx(sq, 32, lane);
                const float rn = rsq(sq * (1.0f / 128.0f) + EPS) * (1.0f - a.lam_init);
#pragma unroll
                for (int v = 0; v < 4; ++v)
#pragma unroll
                    for (int g = 0; g < 4; ++g) { const f32x4 sg = *(const f32x4*)(a.subg + v * 32 + 8 * g + 4 * h);
#pragma unroll
                        for (int j = 0; j < 4; ++j) O[v][4 * g + j] *= rn * sg[j]; SCHED_B; }
            }
        } else {
#pragma unroll
            for (int v = 0; v < 4; ++v)
#pragma unroll
                for (int i = 0; i < 16; ++i) O[v][i] *= inv;
        }
    }
    {
        const int lane = lane_asm(), r = lane & 31, h = lane >> 5;
        LAS unsigned char* st = lds + wid * (32 * 272);
#pragma unroll
        for (int v = 0; v < 4; ++v)
#pragma unroll
            for (int g = 0; g < 4; ++g) { u32x2 w; w.x = pk2(O[v][4 * g], O[v][4 * g + 1]); w.y = pk2(O[v][4 * g + 2], O[v][4 * g + 3]); *(LAS u32x2*)(st + r * 272 + (v * 32 + 8 * g + 4 * h) * 2) = w; }
        asm volatile("s_waitcnt lgkmcnt(0)" ::: "memory");
        constexpr int OP = DIFF ? 1024 : 2048;
        if (!a.dry)
#pragma unroll
        for (int k = 0; k < 8; ++k) { const int id = lane + 64 * k, row = id >> 4, cc = id & 15;
            const u32x4 w = *(const LAS u32x4*)(st + row * 272 + cc * 16);
            *(u32x4*)(a.O + ((size_t)b * S + qw + row) * OP + head * 128 + cc * 8) = w; }
    }
}

template <bool DIFF>
DI void attn_phase(const AttnArgs& a, LAS unsigned char* lds, const int wid) {
    constexpr int BH = DIFF ? 32 : 64, NU = BH * 16, NHD = DIFF ? 8 : 16;
    const int G = gridDim.x, c = blockIdx.x;
    for (int k = 0;; ++k) {
        const long base = (long)k * G; if (base >= NU) break;
        const long ul = (k & 1) ? base + (G - 1 - c) : base + c;
        if (ul >= NU) continue;
        const int u = (int)ul, qb = 15 - u / BH, bh = u % BH;
        attn_unit<DIFF>(a, lds, bh / NHD, bh % NHD, qb, wid);
    }
    __syncthreads();
}

DI int wmap(int mode, int n0) {
    if (mode == 1) { const int tile = n0 >> 8, p = n0 & 255; return tile * 256 + ((p >> 5) & 3) * 64 + (p >> 7) * 32; }
    if (mode == 2) { const int tile = n0 >> 8, p = n0 & 255; return (p >> 7) * DFF + tile * 128 + (p & 127); }
    if (mode == 3) { if (n0 < 2048) return 192 * (n0 >> 7) + (n0 & 127); const int q = n0 - 2048, tile = q >> 8, p = q & 255; return 192 * (tile * 4 + ((p >> 5) & 3)) + 128 + 32 * (p >> 7); }
    return n0;
}
DI void convert_w(const float* W, int K, int Nsrc, const float* gain, bf16_t* dst, int ndst, int mode, LAS float* scr, int gw, int NGW, int& rot) {
    const int lane = lane_asm();
    if (ndst % 64 == 0) {
        const int nblk = ndst / 64, items = (K / 32) * nblk;
        int first = gw - rot; if (first < 0) first += NGW;
        rot = (rot + items) % NGW;
        for (int it = first; it < items; it += NGW) {
            const int kb = it / nblk, nb = it % nblk, k0 = 32 * kb, n0 = 64 * nb, sc = wmap(mode, n0 + (lane & 32)) + (lane & 31);
            float wv[32];
#pragma unroll
            for (int i = 0; i < 32; ++i) wv[i] = W[(size_t)(k0 + i) * Nsrc + sc];
            if (gain) {
#pragma unroll
                for (int i = 0; i < 32; ++i) wv[i] *= gain[k0 + i];
            }
#pragma unroll
            for (int i = 0; i < 32; ++i) scr[i * 65 + lane] = wv[i];
            asm volatile("s_waitcnt lgkmcnt(0)" ::: "memory");
            const int c4 = lane & 3;
#pragma unroll
            for (int j = 0; j < 4; ++j) { const int n = (lane >> 2) + 16 * j; const LAS float* sp = scr + (8 * c4) * 65 + n;
                u32x4 o; o.x = pk2(sp[0 * 65], sp[1 * 65]); o.y = pk2(sp[2 * 65], sp[3 * 65]); o.z = pk2(sp[4 * 65], sp[5 * 65]); o.w = pk2(sp[6 * 65], sp[7 * 65]);
                *(u32x4*)(dst + (size_t)(n0 + n) * K + k0 + 8 * c4) = o; }
            asm volatile("s_waitcnt lgkmcnt(0)" ::: "memory");
        }
        return;
    }
    const int nblk = ndst / 32, items = (K / 64) * nblk;
    int first = gw - rot; if (first < 0) first += NGW;
    rot = (rot + items) % NGW;
    for (int it = first; it < items; it += NGW) {
        const int kb = it / nblk, nb = it % nblk, k0 = 64 * kb, n0 = 32 * nb, sc0 = wmap(mode, n0);
        float wv[32];
#pragma unroll
        for (int i = 0; i < 32; ++i) { const int kk = 2 * i + (lane >> 5); wv[i] = W[(size_t)(k0 + kk) * Nsrc + sc0 + (lane & 31)]; }
        if (gain) {
#pragma unroll
            for (int i = 0; i < 32; ++i) wv[i] *= gain[k0 + 2 * i + (lane >> 5)];
        }
#pragma unroll
        for (int i = 0; i < 32; ++i) { const int kk = 2 * i + (lane >> 5); scr[kk * 33 + (lane & 31)] = wv[i]; }
        asm volatile("s_waitcnt lgkmcnt(0)" ::: "memory");
        const int c8 = lane & 7;
#pragma unroll
        for (int j = 0; j < 4; ++j) { const int n = (lane >> 3) + 8 * j; const LAS float* s = scr + (8 * c8) * 33 + n;
            u32x4 o; o.x = pk2(s[0 * 33], s[1 * 33]); o.y = pk2(s[2 * 33], s[3 * 33]); o.z = pk2(s[4 * 33], s[5 * 33]); o.w = pk2(s[6 * 33], s[7 * 33]);
            *(u32x4*)(dst + (size_t)(n0 + n) * K + k0 + 8 * c8) = o; }
        asm volatile("s_waitcnt lgkmcnt(0)" ::: "memory");
    }
}

DI void norm128_inplace(bf16_t* buf, const float* ss, int ss_stride, const float* gain, float scale, int gw, int NGW, bool dry = false) {
    const int ln = lane_asm();
    const long total = (long)T * 16 * 16;
    for (long base = (long)gw * 512; base < total; base += (long)NGW * 512) {
        u32x4 w[8]; float rs[8];
#pragma unroll
        for (int k = 0; k < 8; ++k) { const long id = base + k * 64 + ln; w[k] = *(const u32x4*)(buf + id * 8); rs[k] = sum4(ss + (id >> 4) * ss_stride); }
#pragma unroll
        for (int k = 0; k < 8; ++k) {
            const long id = base + k * 64 + ln; const int c8 = (int)(id & 15) * 8;
            const float r = rsq(rs[k] * (1.0f / 128.0f) + EPS) * scale;
            const f32x4 g0 = *(const f32x4*)(gain + c8), g1 = *(const f32x4*)(gain + c8 + 4);
            u32x4 o; o.x = pk2(bf_lo(w[k].x) * g0[0] * r, bf_hi(w[k].x) * g0[1] * r); o.y = pk2(bf_lo(w[k].y) * g0[2] * r, bf_hi(w[k].y) * g0[3] * r);
            o.z = pk2(bf_lo(w[k].z) * g1[0] * r, bf_hi(w[k].z) * g1[1] * r); o.w = pk2(bf_lo(w[k].w) * g1[2] * r, bf_hi(w[k].w) * g1[3] * r);
            *(u32x4*)(buf + id * 8) = dry ? w[k] : o;
        }
    }
}
DI void qpe_inplace(bf16_t* Qp, const float* ss_q, const float* gain, const f32x2* cstab, float scale, long g0, long NGT, bool dry = false) {
    for (long th = g0; th < (long)T * 16; th += NGT) {
        const long tk = th >> 4;
        u32x4 w[8];
#pragma unroll
        for (int k = 0; k < 8; ++k) w[k] = *(const u32x4*)(Qp + th * 64 + k * 8);
        const float r = rsq((ss_q[th * 8 + 4] + ss_q[th * 8 + 5]) * (1.0f / 64.0f) + EPS) * scale;
#pragma unroll
        for (int k = 0; k < 4; ++k) {
            float x1[8], x2[8], y1[8], y2[8];
            x1[0] = bf_lo(w[k].x); x1[1] = bf_hi(w[k].x); x1[2] = bf_lo(w[k].y); x1[3] = bf_hi(w[k].y); x1[4] = bf_lo(w[k].z); x1[5] = bf_hi(w[k].z); x1[6] = bf_lo(w[k].w); x1[7] = bf_hi(w[k].w);
            x2[0] = bf_lo(w[k + 4].x); x2[1] = bf_hi(w[k + 4].x); x2[2] = bf_lo(w[k + 4].y); x2[3] = bf_hi(w[k + 4].y); x2[4] = bf_lo(w[k + 4].z); x2[5] = bf_hi(w[k + 4].z); x2[6] = bf_lo(w[k + 4].w); x2[7] = bf_hi(w[k + 4].w);
#pragma unroll
            for (int j = 0; j < 8; j += 2) {
                const f32x4 cs2 = *(const f32x4*)(cstab + tk * 32 + k * 8 + j);
                const f32x2 ga = *(const f32x2*)(gain + k * 8 + j), gb = *(const f32x2*)(gain + 32 + k * 8 + j);
                const float u1a = x1[j] * ga.x * r, u2a = x2[j] * gb.x * r, u1b = x1[j + 1] * ga.y * r, u2b = x2[j + 1] * gb.y * r;
                y1[j] = u1a * cs2[0] - u2a * cs2[1]; y2[j] = u1a * cs2[1] + u2a * cs2[0];
                y1[j + 1] = u1b * cs2[2] - u2b * cs2[3]; y2[j + 1] = u1b * cs2[3] + u2b * cs2[2];
            }
            u32x4 o1, o2;
            o1.x = pk2(y1[0], y1[1]); o1.y = pk2(y1[2], y1[3]); o1.z = pk2(y1[4], y1[5]); o1.w = pk2(y1[6], y1[7]);
            o2.x = pk2(y2[0], y2[1]); o2.y = pk2(y2[2], y2[3]); o2.z = pk2(y2[4], y2[5]); o2.w = pk2(y2[6], y2[7]);
            *(u32x4*)(Qp + th * 64 + k * 8) = dry ? w[k] : o1; *(u32x4*)(Qp + th * 64 + 32 + k * 8) = dry ? w[k + 4] : o2;
        }
    }
}

#define XB_TMO      128
#define XB_XCNT(j)  (256  + 64 * (j))
#define XB_XSUB(j)  (1280 + 64 * (j))
#define XB_XGEN(j)  (2304 + 64 * (j))
#define XB_TOP      3328
#define XB_TOPGEN   3392
#define XCD_BAR_WORDS 3456
#define XB_SPIN_CAP (1u << 18)

__device__ __forceinline__ unsigned xb_ld(unsigned* p)              { return __hip_atomic_load(p, __ATOMIC_RELAXED, __HIP_MEMORY_SCOPE_AGENT); }
__device__ __forceinline__ unsigned xb_add(unsigned* p, unsigned v) { return __hip_atomic_fetch_add(p, v, __ATOMIC_RELAXED, __HIP_MEMORY_SCOPE_AGENT); }
__device__ __forceinline__ unsigned xb_xcc_id() { return (unsigned)__builtin_amdgcn_s_getreg((3 << 11) | 20) & 0xFu; }
#define XB_SPIN(cond, bar) do { unsigned _sp = 0; while (cond) { __builtin_amdgcn_s_sleep(1); \
    if ((++_sp & 255u) == 0u) { if (xb_ld(&(bar)[XB_TMO])) break; if (_sp > XB_SPIN_CAP) { atomicAdd(&(bar)[XB_TMO], 1u); break; } } } } while (0)

struct XcdBarrier {
    unsigned* bar; unsigned x;
    volatile LAS unsigned* st;
};

__device__ __forceinline__ XcdBarrier xcd_barrier_post(unsigned* bar, volatile LAS unsigned* st, const int xb_wid) {
    XcdBarrier b; b.bar = bar; b.x = xb_xcc_id(); b.st = st;
    if ((xb_wid == 0 && lane_asm() == 0)) (void)xb_add(&bar[XB_XCNT(b.x)], 1u);
    return b;
}
__device__ __forceinline__ void xcd_barrier_complete(unsigned* bar, unsigned x, unsigned& nloc, unsigned& nx) {
    const unsigned G = gridDim.x * gridDim.y * gridDim.z;
    unsigned sum, cnt, mine, sp = 0u;
    for (;;) {
        sum = 0u; cnt = 0u; mine = 0u;
#pragma unroll
        for (unsigned j = 0; j < 16; ++j) { const unsigned c = xb_ld(&bar[XB_XCNT(j)]); sum += c; cnt += (c > 0u) ? 1u : 0u; mine = (j == x) ? c : mine; }
        if (sum == G) break;
        __builtin_amdgcn_s_sleep(1);
        if ((++sp & 255u) == 0u) { if (xb_ld(&bar[XB_TMO])) break; if (sp > XB_SPIN_CAP) { atomicAdd(&bar[XB_TMO], 1u); break; } }
    }
    nloc = mine > 0u ? mine : 1u; nx = cnt > 0u ? cnt : 1u;
}

__device__ __forceinline__ void xcd_barrier(const XcdBarrier& b, const int xb_wid) {
    asm volatile("s_waitcnt vmcnt(0)" ::: "memory");
    __syncthreads();
    if ((xb_wid == 0 && lane_asm() == 0)) {
        unsigned* bar = b.bar;
        __builtin_amdgcn_s_waitcnt(0);
        unsigned nloc = b.st[0], nx = b.st[1];
        if (nloc == 0u) { xcd_barrier_complete(bar, b.x, nloc, nx); b.st[0] = nloc; b.st[1] = nx; }
        const unsigned old = xb_add(&bar[XB_XSUB(b.x)], 1u);
        const unsigned gen = old / nloc;
        if (old + 1u == (gen + 1u) * nloc) {
            __builtin_amdgcn_fence(__ATOMIC_RELEASE, "agent");
            asm volatile("s_waitcnt vmcnt(0)" ::: "memory");
            const unsigned og = xb_add(&bar[XB_TOP], 1u);
            const unsigned tg = og / nx;
            if (og + 1u == (tg + 1u) * nx) xb_add(&bar[XB_TOPGEN], 1u);
            else XB_SPIN(xb_ld(&bar[XB_TOPGEN]) == tg, bar);
            __builtin_amdgcn_fence(__ATOMIC_ACQUIRE, "agent");
            xb_add(&bar[XB_XGEN(b.x)], 1u);
            asm volatile("s_waitcnt vmcnt(0)" ::: "memory");
        } else {
            XB_SPIN(xb_ld(&bar[XB_XGEN(b.x)]) == gen, bar);
            __builtin_amdgcn_fence(__ATOMIC_ACQUIRE, "agent");
            asm volatile("s_waitcnt vmcnt(0)" ::: "memory");
        }
    }
    __syncthreads();
}

struct Args { const void* in[34]; float* out; unsigned char* ws; long probe; };

__global__ void __launch_bounds__(512, 2) fwd_kernel(Args args) {
    extern __shared__ __attribute__((aligned(16))) unsigned char lds_raw[];
    LAS unsigned char* lds = (LAS unsigned char*)lds_raw;
    cg::grid_group grid = cg::this_grid();
    const int wid = __builtin_amdgcn_readfirstlane(threadIdx.x >> 6);
    const int G = gridDim.x, gw = blockIdx.x * 8 + wid, NGW = G * 8;
    const long NGT = (long)G * 512;
#define ltid() (wid * 64 + lane_asm())
#define gtid ((long)blockIdx.x * 512 + ltid())
#define NREP(bit) (1 + ((PROBE_BITS >> (bit)) & 1))
#define PDRY(c) ((c) && KARGS()->probe != 0)
    unsigned char* ws = args.ws;
    float* ssb = (float*)(ws + WS_SS);
    bf16_t* PB = (bf16_t*)(ws + WS_PB);
    bf16_t* WATT = (bf16_t*)(ws + WS_WATT);
    bf16_t* WFFN = (bf16_t*)(ws + WS_WFFN);
    bf16_t* X = (bf16_t*)(ws + WS_X);
    bf16_t* Y = (bf16_t*)(ws + WS_Y);
    bf16_t* R3 = (bf16_t*)(ws + WS_R3);
    bf16_t* R4 = (bf16_t*)(ws + WS_R4);
    LAS float* scr = (LAS float*)(lds + wid * 16384);
    f32x2* cstab = (f32x2*)(ws + WS_CS);
    int* pmaxb = (int*)(ws + WS_SS + 4 * MiB);
#define XIN INF(0)
#define PIN INF(1)
#define POSIN ((const int*)INF(2))
    typedef const Args __attribute__((address_space(4)))* KArgsP;
#define KARGS() ({ KArgsP kp_ = (KArgsP)__builtin_amdgcn_kernarg_segment_ptr(); asm volatile("" : "+s"(kp_)); kp_; })
#define INF(i) ((const float*)KARGS()->in[i])
    float* hout = args.out;
    { volatile LAS unsigned* st0 = (volatile LAS unsigned*)(lds + BARST_OFF); { const int l0 = lane_asm(); if (wid == 0 && l0 < 2) st0[l0] = 0u; } __syncthreads(); }
    const XcdBarrier xbar = xcd_barrier_post((unsigned*)(ws + WS_CTL), (volatile LAS unsigned*)(lds + BARST_OFF), wid);
#define GSYNC() do { xcd_barrier(xbar, wid); if (PROBE_BITS & 4) xcd_barrier(xbar, wid); } while (0)
    bf16_t* Wqkv_t = WATT; bf16_t* WoA_t = WATT + 3 * MiB;
    bf16_t* Wdq_t = WATT; bf16_t* Wuq_t = WATT + 1 * MiB; bf16_t* WoB_t = WATT + (5 * MiB) / 2; bf16_t* Wukv_t = WATT + (9 * MiB) / 2;
    bf16_t* Win_t = WFFN; bf16_t* Wout_t = WFFN + (11 * MiB) / 2; bf16_t* Wg_t = WFFN + (33 * MiB) / 4; bf16_t* Wp_t = WFFN + (37 * MiB) / 4;

    auto conv_attn = [&](int layer) {
        int rot = 0;
        if (layer < 2) {
            convert_w(INF(5) + (size_t)layer * 1024 * 3072, 1024, 3072, INF(4) + layer * 1024, Wqkv_t, 3072, 1, scr, gw, NGW, rot);
            convert_w(INF(13) + (size_t)layer * 1024 * 1024, 1024, 1024, nullptr, WoA_t, 1024, 0, scr, gw, NGW, rot);
        } else {
            const int j = layer - 2;
            convert_w(INF(20) + (size_t)j * 1024 * 512, 1024, 512, INF(4) + layer * 1024, Wdq_t, 512, 0, scr, gw, NGW, rot);
            if (j == 0) {
                convert_w(INF(15), 1024, 320, INF(14), Wdq_t + 512 * 1024, 256, 0, scr, gw, NGW, rot);
                convert_w(INF(15) + 256, 1024, 320, INF(14), Wdq_t + 768 * 1024, 32, 0, scr, gw, NGW, rot);
                convert_w(INF(15) + 288, 1024, 320, INF(14), Wdq_t + 896 * 1024, 32, 0, scr, gw, NGW, rot);
                convert_w(INF(17), 256, 4096, INF(16), Wukv_t, 4096, 0, scr, gw, NGW, rot);
            }
            convert_w(INF(22) + (size_t)j * 512 * 3072, 512, 3072, INF(21) + j * 512, Wuq_t, 3072, 3, scr, gw, NGW, rot);
            convert_w(INF(25) + (size_t)j * 2048 * 1024, 2048, 1024, nullptr, WoB_t, 1024, 0, scr, gw, NGW, rot);
        }
    };
    auto conv_ffn = [&](int layer) {
        int rot = 0;
        convert_w(INF(27) + (size_t)layer * 1024 * 5632, 1024, 5632, INF(26) + layer * 1024, Win_t, 5632, 2, scr, gw, NGW, rot);
        convert_w(INF(30) + (size_t)layer * DFF * 1024, DFF, 1024, nullptr, Wout_t, 1024, 0, scr, gw, NGW, rot);
        convert_w(INF(33) + (size_t)layer * 1024 * 1024, 1024, 1024, INF(31) + layer * 1024, Wg_t, 1024, 0, scr, gw, NGW, rot);
        convert_w(INF(32) + (size_t)layer * 256 * 1024, 256, 1024, nullptr, Wp_t, 1024, 0, scr, gw, NGW, rot);
        const float* pi = PIN + (size_t)layer * T * 256;
        {
            const long i0 = (long)blockIdx.x * 512 + ltid();
            for (long ib = i0; ib < (long)T * 256 / 8; ib += 4 * NGT) {
                f32x4 va[4], vb[4];
#pragma unroll
                for (int k = 0; k < 4; ++k) { const long i = ib + k * NGT; if (i < (long)T * 256 / 8) { va[k] = *(const f32x4*)(pi + i * 8); vb[k] = *(const f32x4*)(pi + i * 8 + 4); } }
#pragma unroll
                for (int k = 0; k < 4; ++k) { const long i = ib + k * NGT; if (i < (long)T * 256 / 8) {
                    u32x4 o; o.x = pk2(va[k][0], va[k][1]); o.y = pk2(va[k][2], va[k][3]); o.z = pk2(vb[k][0], vb[k][1]); o.w = pk2(vb[k][2], vb[k][3]);
                    *(u32x4*)(PB + i * 8) = o; } }
            }
        }
    };

    conv_attn(0);
    for (long i = gtid; i < 512; i += NGT) {
        typedef int i32x4 __attribute__((ext_vector_type(4)));
        const i32x4* pp_ = (const i32x4*)(POSIN + i * 32); i32x4 q_[8]; int mxp;
#pragma unroll
        for (int k = 0; k < 8; ++k) q_[k] = pp_[k];
        mxp = q_[0][0];
#pragma unroll
        for (int k = 0; k < 8; ++k)
#pragma unroll
            for (int e = 0; e < 4; ++e) mxp = q_[k][e] > mxp ? q_[k][e] : mxp;
        pmaxb[i] = mxp;
    }
    for (long i = gtid; i < (long)T * 32; i += NGT) {
        const int d = (int)(i & 31);
        const float ang = (float)POSIN[i >> 5] * expf(-9.210340371976184f * (float)d * (2.0f / 64.0f));
        float sn, cs; sincosf(ang, &sn, &cs);
        cstab[i] = (f32x2){cs, sn};
    }
    for (int m = gw; m < T; m += NGW) {
        const int ln = lane_asm();
        const f32x4* xr = (const f32x4*)(XIN + (size_t)m * D) + ln; float sq = 0.f; f32x4 v[4];
#pragma unroll
        for (int j = 0; j < 4; ++j) { v[j] = xr[64 * j]; sq += dot4(v[j]); }
        sq = wave_sum(sq, ln); if (ln < 16) ssb[(size_t)m * 16 + ln] = (ln == 0) ? sq : 0.f;
#pragma unroll
        for (int j = 0; j < 4; ++j) store_bf4(X + (size_t)m * D + 4 * ln + 256 * j, v[j]);
    }
    grid.sync();

    for (int layer = 0; layer < 4; ++layer) {
        bf16_t* IN = (layer & 1) ? Y : X; bf16_t* OT = (layer & 1) ? X : Y;
        float* ss_in = ssb + (size_t)SS_IN * T;
        float* ss_h1 = ssb + (size_t)SS_H1 * T;
        float* ss_h2 = ssb + (size_t)SS_H2 * T;
        bf16_t* Obuf; const bf16_t* WoT; int Ko;
        if (layer < 2) {
            bf16_t* QA = R3; bf16_t* KA = R3 + 16 * MiB; bf16_t* VtA = R3 + 32 * MiB;
            {
                pg8::Gemm g{IN, Wqkv_t, 1024, 0}; pg8::StaticOrder So; So.init(64, 12, G, blockIdx.x);
                EpiQkvA E{ss_in, INF(6) + layer * 64, INF(7) + layer * 64, QA, KA, VtA};

#ifndef NO_QKVA
                pg8::gemm_phase<EpiQkvA, true>(lds, g, So, E, wid, NREP(4), PROBE_BITS ? KARGS()->probe : 0);
#endif

            }
            GSYNC();
            {
                for (int rep = 0; rep < NREP(11); ++rep) conv_ffn(layer);
                AttnArgs a{}; a.Q = QA; a.K = KA; a.Vt = VtA; a.O = QA; a.pos = POSIN; a.rel = INF(3); a.pmax = pmaxb;
                a.lq1 = INF(8) + layer * 64; a.lk1 = INF(9) + layer * 64; a.lq2 = INF(10) + layer * 64; a.lk2 = INF(11) + layer * 64; a.subg = INF(12) + layer * 128;
                a.lam_init = (layer == 0) ? 0.2f : 0.35550906759096926f;

#ifndef NO_ATTN_DIFF
                { const int nrep = NREP(0); for (int rep = 0; rep < nrep; ++rep) { a.dry = PDRY(rep < nrep - 1) ? (1 | (int)((KARGS()->probe >> 14) & 7) << 1) : 0; attn_phase<true>(a, lds, wid); } }
#endif

            }
            GSYNC();
            Obuf = QA; WoT = WoA_t; Ko = 1024;
        } else {
            const int j = layer - 2;
            bf16_t* Kn = R3; bf16_t* VtB = R3 + 32 * MiB; bf16_t* Kpe = R3 + 64 * MiB;
            bf16_t* Qn = R4; bf16_t* Qp = R4 + 32 * MiB;
            bf16_t* cq = OT; bf16_t* ckv = OT + 8 * MiB;
            float* ss_cq = ssb + (size_t)SS_CQ * T; float* ss_ckv = ssb + (size_t)SS_CKV * T;
            {
                pg8::Gemm g{IN, Wdq_t, 1024, 0}; pg8::StaticOrder So; So.init(64, j == 0 ? 4 : 2, G, blockIdx.x);
                EpiDq E{ss_in, cq, ckv, Kpe, INF(19), cstab, ss_cq, ss_ckv};

#ifndef NO_DQ
                pg8::gemm_phase<EpiDq, true>(lds, g, So, E, wid, NREP(9), PROBE_BITS ? KARGS()->probe : 0);
#endif

            }
            GSYNC();
            {
                { pg8::Gemm g{cq, Wuq_t, 512, 0}; pg8::StaticOrder So; So.init(64, 12, G, blockIdx.x); EpiUq E{ss_cq, Qn, Qp, INF(23) + j * 128, INF(24) + j * 64, cstab, (LAS float*)(lds + XCH_OFF)};
#ifndef NO_UQ
 pg8::gemm_phase<EpiUq, true>(lds, g, So, E, wid, NREP(10), PROBE_BITS ? KARGS()->probe : 0);
#endif
 }
                if (j == 0) { pg8::Gemm g{ckv, Wukv_t, 256, 0}; pg8::StaticOrder So; So.init(64, 16, G, blockIdx.x); EpiUkv E{ss_ckv, Kn, VtB, INF(18), (LAS float*)(lds + XCH_OFF)};
#ifndef NO_UKV
 pg8::gemm_phase<EpiUkv, true>(lds, g, So, E, wid, NREP(10), PROBE_BITS ? KARGS()->probe : 0);
#endif
 }
            }
            GSYNC();
            {
                for (int rep = 0; rep < NREP(11); ++rep) conv_ffn(layer);
                AttnArgs a{}; a.Q = Qn; a.Q2 = Qp; a.K = Kn; a.K2 = Kpe; a.Vt = VtB; a.O = Qn; a.pos = POSIN;
                a.gn = INF(23) + j * 128; a.gp = INF(24) + j * 64; a.cs = cstab;

#ifndef NO_ATTN_MLA
                { const int nrep = NREP(1); for (int rep = 0; rep < nrep; ++rep) { a.dry = PDRY(rep < nrep - 1); attn_phase<false>(a, lds, wid); } }
#endif

            }
            GSYNC();
            Obuf = Qn; WoT = WoB_t; Ko = 2048;
        }
        {
            pg8::Gemm g{Obuf, WoT, Ko, 0}; pg8::StaticOrder So; So.init(64, 4, G, blockIdx.x);
            EpiRes E{IN, ss_h1};

#ifndef NO_RES
            pg8::gemm_phase<EpiRes, true>(lds, g, So, E, wid, NREP(5), PROBE_BITS ? KARGS()->probe : 0);
#endif
        }
        GSYNC();
        {
            if (layer < 3) { for (int rep = 0; rep < NREP(11); ++rep) conv_attn(layer + 1); __syncthreads(); }
            pg8::Gemm g{IN, Win_t, 1024, 1}; pg8::StaticOrder So; So.init(68, 22, G, blockIdx.x);
            EpiFfnIn E{ss_h1, INF(28) + (size_t)layer * 3 * 5632, INF(29) + (size_t)layer * 5632, R4, (LAS float*)(lds + XCH_OFF)};

#ifndef NO_FFNIN
            pg8::gemm_phase<EpiFfnIn, true>(lds, g, So, E, wid, NREP(6), PROBE_BITS ? KARGS()->probe : 0);
#endif

        }
        GSYNC();
        {
            { pg8::Gemm g{R4, Wout_t, DFF, 0}; pg8::StaticOrder So; So.init(64, 4, G, blockIdx.x); EpiRes E{IN, ss_h2};
#ifndef NO_RES
 pg8::gemm_phase<EpiRes, true>(lds, g, So, E, wid, NREP(7), PROBE_BITS ? KARGS()->probe : 0);
#endif
 }
            { pg8::Gemm g{PB, Wp_t, 256, 0}; pg8::StaticOrder So; So.init(64, 4, G, blockIdx.x); EpiPlain E{OT};
#ifndef NO_PLAIN
 pg8::gemm_phase<EpiPlain, true>(lds, g, So, E, wid, NREP(7), PROBE_BITS ? KARGS()->probe : 0);
#endif
 }
        }
        GSYNC();
        {
            pg8::Gemm g{IN, Wg_t, 1024, 0}; pg8::StaticOrder So; So.init(64, 4, G, blockIdx.x);
            EpiPle E{IN, OT, layer == 3 ? hout : nullptr, ss_h2, layer < 3 ? ss_in : nullptr};

#ifndef NO_PLE
            pg8::gemm_phase<EpiPle, true>(lds, g, So, E, wid, NREP(8), PROBE_BITS ? KARGS()->probe : 0);
#endif

        }
        if (layer < 3) GSYNC();
    }
}

extern "C" void kernel_launch(void* const* d_in, const int* in_sizes, int n_in, void* d_out, int out_size, void* d_ws, size_t ws_size, hipStream_t stream) {
    static int grid = 0;
    if (grid == 0) {
        if (n_in != 34 || out_size != T * D || ws_size < WS_END) { fprintf(stderr, "kernel_launch: unexpected shapes (n_in %d out %d ws %zu)\n", n_in, out_size, ws_size); grid = -1; return; }
        int dev = 0, cus = 0, per_cu = 0;
        hipGetDevice(&dev); hipDeviceGetAttribute(&cus, hipDeviceAttributeMultiprocessorCount, dev);
        if (hipFuncSetAttribute((const void*)fwd_kernel, hipFuncAttributeMaxDynamicSharedMemorySize, LDS_BYTES) != hipSuccess) { fprintf(stderr, "hipFuncSetAttribute failed\n"); grid = -1; return; }
        hipOccupancyMaxActiveBlocksPerMultiprocessor(&per_cu, (const void*)fwd_kernel, 512, LDS_BYTES);
        if (per_cu < 1) { fprintf(stderr, "occupancy query: %d\n", per_cu); per_cu = 1; }
        grid = cus * 1;
    }
    if (grid < 0) return;
    if (hipMemsetAsync((char*)d_ws + WS_CTL, 0, 16384, stream) != hipSuccess) { fprintf(stderr, "memset failed\n"); return; }
    Args a{};
    for (int i = 0; i < 34; ++i) a.in[i] = d_in[i];
    a.out = (float*)d_out; a.ws = (unsigned char*)d_ws; a.probe = PROBE_BITS;
    void* kargs[] = {&a};
    hipError_t e = hipLaunchCooperativeKernel((const void*)fwd_kernel, dim3(grid), dim3(512), kargs, LDS_BYTES, stream);
    if (e != hipSuccess) fprintf(stderr, "cooperative launch failed: %s (grid %d)\n", hipGetErrorString(e), grid);
}
```
